# Optimizing an MI355X kernel written in HIP

```python
import math
import jax, jax.numpy as jnp
from jax import lax
import numpy as np

D_MODEL = 1024
BATCH = 4
SEQ = 8192
DEPTH = 1

HEAD_DIM = 64
N_HEADS_DIL = 8
N_HEADS_FOX = 8
D_DIL = N_HEADS_DIL * HEAD_DIM
D_FOX = N_HEADS_FOX * HEAD_DIM
D_MIX = D_DIL + D_FOX
D_IN = 3 * D_DIL + 3 * D_FOX + N_HEADS_FOX
DILATED_BRANCHES = ((128, 1), (512, 4), (2048, 16))
SEG = 128
BLOCK_Q = 128
N_BUCKETS = 32
MAX_DISTANCE = 2048
N_GROUPS = 4
EXPERTS_PER_GROUP = 8
N_EXPERTS = N_GROUPS * EXPERTS_PER_GROUP
TOP_K_IN_GROUP = 2
D_EXPERT = 256
EPS = 1e-6
SCALE = HEAD_DIM ** -0.5
NEG_INF = -1e30

kernel_name = "hymba_dilated_fox_hmoe_layer"


def _rmsnorm(x, g):
    x32 = x.astype(jnp.float32)
    y = x32 * lax.rsqrt(jnp.mean(x32 * x32, axis=-1, keepdims=True) + EPS)
    return (y * g.astype(jnp.float32)).astype(x.dtype)


def _t5_bucket(dist):
    max_exact = N_BUCKETS // 2
    d32 = jnp.maximum(dist, 1).astype(jnp.float32)
    large = max_exact + (jnp.log(d32 / max_exact) / math.log(MAX_DISTANCE / max_exact)
                         * (N_BUCKETS - max_exact)).astype(jnp.int32)
    large = jnp.minimum(large, N_BUCKETS - 1)
    return jnp.where(dist < max_exact, dist, large)


def _dilated_branch(q, k, v, rel_bias, dilation):
    B, T, H, Dh = q.shape
    L = T // dilation
    nb = -(-L // SEG)
    L_pad = nb * SEG

    def to_sub(a):
        a = a.reshape(B, L, dilation, H, Dh).transpose(0, 2, 1, 3, 4)
        a = jnp.pad(a, ((0, 0), (0, 0), (0, L_pad - L), (0, 0), (0, 0)))
        return a.reshape(B, dilation, nb, SEG, H, Dh)

    qs, ks, vs = to_sub(q), to_sub(k), to_sub(v)

    def with_prev(a):
        prev = jnp.pad(a, ((0, 0), (0, 0), (1, 0), (0, 0), (0, 0), (0, 0)))[:, :, :-1]
        return jnp.concatenate([prev, a], axis=3)

    kk, vv = with_prev(ks), with_prev(vs)

    i = jnp.arange(SEG)[:, None]
    j = jnp.arange(2 * SEG)[None, :]
    m = i - j + SEG
    band = (m >= 0) & (m <= SEG)
    bias = rel_bias[_t5_bucket(jnp.clip(m, 0, SEG) * dilation)]
    bias = bias.transpose(2, 0, 1).astype(jnp.float32)
    blk = jnp.arange(nb)[:, None, None]
    valid = band[None] & (blk * SEG - SEG + j[None] >= 0)

    s = jnp.einsum('brnqhd,brnkhd->brnhqk', qs, kk,
                   preferred_element_type=jnp.float32) * SCALE + bias
    s = jnp.where(valid[:, None], s, NEG_INF)
    mx = jnp.max(s, axis=-1, keepdims=True)
    p = jnp.exp(s - mx)
    den = jnp.sum(p, axis=-1, keepdims=True)
    o = jnp.einsum('brnhqk,brnkhd->brnqhd', (p / den).astype(v.dtype), vv)
    lse = (mx + jnp.log(den))[..., 0].transpose(0, 1, 2, 4, 3)

    def from_sub(a):
        a = a.reshape(B, dilation, L_pad, *a.shape[4:])[:, :, :L]
        a = jnp.moveaxis(a, 1, 2)
        return a.reshape(B, T, *a.shape[3:])

    return from_sub(o), from_sub(lse)


def _dilated_attention(q, k, v, rel_bias):
    outs, lses = [], []
    for _, dilation in DILATED_BRANCHES:
        o, l = _dilated_branch(q, k, v, rel_bias, dilation)
        outs.append(o)
        lses.append(l)
    w = jax.nn.softmax(jnp.stack(lses), axis=0)
    return jnp.einsum('gbth,gbthd->bthd', w.astype(q.dtype), jnp.stack(outs))


def _forgetting_attention(q, k, v, log_f):
    B, T, H, Dh = q.shape
    nq = T // BLOCK_Q
    c = jnp.cumsum(log_f, axis=1)
    c_k = c.transpose(0, 2, 1)
    k_pos = jnp.arange(T)
    qb = q.reshape(B, nq, BLOCK_Q, H, Dh).transpose(1, 0, 2, 3, 4)
    cb = c.reshape(B, nq, BLOCK_Q, H).transpose(1, 0, 3, 2)
    starts = jnp.arange(nq) * BLOCK_Q

    def block(args):
        qi, ci, t0 = args
        s = jnp.einsum('bqhd,bkhd->bhqk', qi, k, preferred_element_type=jnp.float32) * SCALE
        s = s + ci[..., None] - c_k[:, :, None, :]
        q_pos = t0 + jnp.arange(BLOCK_Q)
        s = jnp.where(k_pos[None, :] <= q_pos[:, None], s, NEG_INF)
        p = jax.nn.softmax(s, axis=-1)
        return jnp.einsum('bhqk,bkhd->bqhd', p.astype(v.dtype), v)

    o = lax.map(block, (qb, cb, starts))
    return o.transpose(1, 0, 2, 3, 4).reshape(B, T, H, Dh)


def _hierarchical_moe(xt, w_rg, b_rg, w_re, b_re, w_gate, w_up, w_down):
    N = xt.shape[0]
    group_logits = (xt @ w_rg + b_rg).astype(jnp.float32)
    group_probs = jax.nn.softmax(group_logits, axis=-1)
    g1, g_idx = lax.top_k(group_probs, 1)
    expert_logits = (xt @ w_re + b_re).astype(jnp.float32).reshape(N, N_GROUPS, EXPERTS_PER_GROUP)
    sel = jnp.take_along_axis(expert_logits, g_idx[:, :, None], axis=1)[:, 0]
    top_v, top_i = lax.top_k(sel, TOP_K_IN_GROUP)
    g2 = jax.nn.softmax(top_v, axis=-1)
    expert_id = g_idx * EXPERTS_PER_GROUP + top_i
    combine = jnp.sum(jax.nn.one_hot(expert_id, N_EXPERTS, dtype=jnp.float32)
                      * (g1 * g2)[..., None], axis=1).astype(xt.dtype)
    y = jnp.zeros_like(xt)
    for e in range(N_EXPERTS):
        he = jax.nn.silu(xt @ w_gate[e]) * (xt @ w_up[e])
        y = y + combine[:, e:e + 1] * (he @ w_down[e])
    return y


def setup_inputs(seed: int = 0) -> dict:
    key = jax.random.key(seed)
    ks = jax.random.split(key, 20)
    f32 = jnp.float32
    nrm = lambda k, shape, s: jax.random.normal(k, shape, f32) * s
    return {
        "x": nrm(ks[0], (BATCH, SEQ, D_MODEL), 1.0),
        "w_in": nrm(ks[1], (DEPTH, D_MODEL, D_IN), D_MODEL ** -0.5),
        "b_forget": 2.0 + nrm(ks[2], (DEPTH, N_HEADS_FOX), 0.5),
        "attn_norm": 1.0 + nrm(ks[3], (DEPTH, D_MODEL), 0.02),
        "out_norm_dil": 1.0 + nrm(ks[4], (DEPTH, D_DIL), 0.02),
        "out_norm_fox": 1.0 + nrm(ks[5], (DEPTH, D_FOX), 0.02),
        "w_out": nrm(ks[6], (DEPTH, D_MIX, D_MODEL), D_MIX ** -0.5),
        "ffn_norm": 1.0 + nrm(ks[7], (DEPTH, D_MODEL), 0.02),
        "w_router_group": nrm(ks[8], (DEPTH, D_MODEL, N_GROUPS), D_MODEL ** -0.5),
        "b_router_group": nrm(ks[9], (DEPTH, N_GROUPS), 0.01),
        "w_router_expert": nrm(ks[10], (DEPTH, D_MODEL, N_EXPERTS), D_MODEL ** -0.5),
        "b_router_expert": nrm(ks[11], (DEPTH, N_EXPERTS), 0.01),
        "w_expert_gate": nrm(ks[12], (DEPTH, N_EXPERTS, D_MODEL, D_EXPERT), D_MODEL ** -0.5),
        "w_expert_up": nrm(ks[13], (DEPTH, N_EXPERTS, D_MODEL, D_EXPERT), D_MODEL ** -0.5),
        "w_expert_down": nrm(ks[14], (DEPTH, N_EXPERTS, D_EXPERT, D_MODEL), D_EXPERT ** -0.5),
        "rel_bias": nrm(ks[15], (N_BUCKETS, N_HEADS_DIL), 0.5),
        "final_norm": 1.0 + nrm(ks[16], (D_MODEL,), 0.02),
    }


def reference(x, w_in, b_forget, attn_norm, out_norm_dil, out_norm_fox, w_out, ffn_norm,
              w_router_group, b_router_group, w_router_expert, b_router_expert,
              w_expert_gate, w_expert_up, w_expert_down, rel_bias, final_norm):
    B, T, D = x.shape
    splits = [D_DIL, 2 * D_DIL, 3 * D_DIL, 3 * D_DIL + D_FOX, 3 * D_DIL + 2 * D_FOX,
              3 * D_DIL + 3 * D_FOX]
    for layer in range(DEPTH):
        h = _rmsnorm(x, attn_norm[layer])
        proj = h @ w_in[layer]
        qa, ka, va, qf, kf, vf, f_pre = jnp.split(proj, splits, axis=-1)
        heads = lambda a, n: a.reshape(B, T, n, HEAD_DIM)
        o_dil = _dilated_attention(heads(qa, N_HEADS_DIL), heads(ka, N_HEADS_DIL),
                                   heads(va, N_HEADS_DIL), rel_bias)
        log_f = jax.nn.log_sigmoid((f_pre + b_forget[layer]).astype(jnp.float32))
        o_fox = _forgetting_attention(heads(qf, N_HEADS_FOX), heads(kf, N_HEADS_FOX),
                                      heads(vf, N_HEADS_FOX), log_f)
        o_dil = _rmsnorm(o_dil.reshape(B, T, D_DIL), out_norm_dil[layer])
        o_fox = _rmsnorm(o_fox.reshape(B, T, D_FOX), out_norm_fox[layer])
        x = x + jnp.concatenate([o_dil, o_fox], axis=-1) @ w_out[layer]
        h2 = _rmsnorm(x, ffn_norm[layer]).reshape(B * T, D)
        y = _hierarchical_moe(h2, w_router_group[layer], b_router_group[layer],
                              w_router_expert[layer], b_router_expert[layer],
                              w_expert_gate[layer], w_expert_up[layer], w_expert_down[layer])
        x = x + y.reshape(B, T, D)
    return _rmsnorm(x, final_norm)
```

```cpp
#include <hip/hip_runtime.h>
#include <hip/hip_bf16.h>
#include <cstdio>
#include <cstdint>

#define GAS __attribute__((address_space(1)))
#define LAS __attribute__((address_space(3)))
typedef unsigned short bf16_t;
typedef short bf16x8 __attribute__((ext_vector_type(8)));
typedef short s16x4 __attribute__((ext_vector_type(4)));
typedef float f32x4 __attribute__((ext_vector_type(4)));
typedef float f32x2 __attribute__((ext_vector_type(2)));
typedef float f32x16 __attribute__((ext_vector_type(16)));
typedef unsigned u32x4 __attribute__((ext_vector_type(4)));
typedef unsigned u32x2 __attribute__((ext_vector_type(2)));
typedef __bf16 bf16x2_t __attribute__((ext_vector_type(2)));

constexpr int BATCH = 4, T = 8192, D = 1024, M = BATCH * T;
constexpr int NH = 8, HD = 64, DH = NH * HD;
constexpr int NQKV = 6 * DH;
constexpr int DIN = NQKV + NH;
constexpr int NE = 32, DE = 256, EPG = 8, NG = 4;
constexpr int CAP = M;
constexpr float EPS = 1e-6f;
constexpr float LOG2E = 1.4426950408889634f;
constexpr float C2 = 0.125f * LOG2E;
constexpr float NEGBIG = -1e30f;

__device__ __forceinline__ unsigned cvt_pk_bf16(float lo, float hi) { f32x2 v = {lo, hi}; bf16x2_t b = __builtin_convertvector(v, bf16x2_t); return __builtin_bit_cast(unsigned, b); }
__device__ __forceinline__ float bf_lo(unsigned w) { return __builtin_bit_cast(float, w << 16); }
__device__ __forceinline__ float bf_hi(unsigned w) { return __builtin_bit_cast(float, w & 0xffff0000u); }

namespace pg8 {
#define PG8_LAS __attribute__((address_space(3)))
constexpr int BM = 256, BK = 64, HALF = 128, HTB = HALF * BK * 2  , STAGE_BYTES = 8 * HTB, NXCD = 8, WGM = 8;

__host__ __device__ __forceinline__ int lds_byte(int r, int c) { const int st = (r >> 4) * 2 + (c >> 5), rr = r & 15, cc = c & 31, ob = rr * 64 + cc * 2; return st * 1024 + (ob ^ (((ob >> 9) & 1) << 5)); }
__host__ __device__ __forceinline__ void stage_rc(int b, int& R, int& C) { const int st = b / 1024, sb = b % 1024, swz = sb ^ (((sb >> 9) & 1) << 5); R = (st >> 1) * 16 + swz / 64; C = (st & 1) * 32 + (swz % 64) / 2; }
__host__ __device__ __forceinline__ int perm32(int rho) { const int n = rho >> 4, i = rho & 15; return 8 * (i >> 2) + 4 * n + (i & 3); }

struct Unit { int pm, pn, e, ti; };
struct Gemm { const bf16_t* A; const bf16_t* Bt; int M, N, K; };

struct StaticOrder {
    int nM, nN, nwg, G, c;
    __host__ __device__ void init(int M_, int N_, int G_, int c_) { nM = M_ / BM; nN = N_ / BM; nwg = nM * nN; G = G_; c = c_; }
    __host__ __device__ bool next(int i, Unit& u) const {
        const long L = (long)i * G + c; if (L >= nwg) return false;
        int wgid = (int)L; { const int q = nwg / NXCD, r = nwg % NXCD, xcd = wgid % NXCD, off = wgid / NXCD; wgid = (xcd < r ? xcd * (q + 1) : r * (q + 1) + (xcd - r) * q) + off; }
        const int nig = WGM * nN, gid = wgid / nig, fm = gid * WGM, gsz = (nM - fm) < WGM ? (nM - fm) : WGM;
        u.pm = fm + ((wgid % nig) % gsz); u.pn = (wgid % nig) / gsz; u.e = 0; u.ti = 0; return true;
    }
    __device__ __forceinline__ int row_token(const Unit&, int) const { return 0; }
};

template <int SH> struct MoeOrder {
    static constexpr int npn = 1 << SH;
    const PG8_LAS int* pre; const PG8_LAS int* cnt; const int* list_tok; int G, c;
    __device__ __forceinline__ bool next(int i, Unit& u) const {
        const int L = i * G + c, total = __builtin_amdgcn_readfirstlane(pre[32]);
        if (L >= total * npn) return false;
        const int tf = L >> SH, pn = L & (npn - 1);
        int e = 0;
#pragma unroll 1
        for (int k = 16; k >= 1; k >>= 1) { const int pv = __builtin_amdgcn_readfirstlane(pre[e + k]); if (pv <= tf) e += k; }
        const int pe = __builtin_amdgcn_readfirstlane(pre[e]);
        u.e = e; u.ti = tf - pe; u.pm = tf; u.pn = e * npn + pn; return true;
    }
    __device__ __forceinline__ int row_token(const Unit& u, int r) const { int idx = u.ti * 256 + r; idx = idx < cnt[u.e] ? idx : 0; return list_tok[(size_t)u.e * CAP + idx] >> 1; }
};

template <class Epi, class Sched, bool GATHER>
__device__ __forceinline__ void gemm_phase(PG8_LAS unsigned char* lds, const Gemm g, const Sched& S, const Epi& E) {
    const int tid = threadIdx.x, wid = __builtin_amdgcn_readfirstlane(tid >> 6), lane = tid & 63, wr = wid >> 2, wc = wid & 3, fr = lane & 15, fq = lane >> 4;
    const int K = g.K, nt = K / BK;
    unsigned voffA[2], voffB[2]; int RA[2], CA[2];
#pragma unroll
    for (int i = 0; i < 2; ++i) { int R, C; stage_rc(tid * 16 + i * 8192, R, C); const int Rb = Epi::PERM ? ((R & ~31) + perm32(R & 31)) : R;
        voffA[i] = (unsigned)(R * K + C) * 2u; voffB[i] = (unsigned)(Rb * K + C) * 2u; RA[i] = R; CA[i] = C; }
    const size_t kstep = (size_t)(BK * 2);
    const size_t hstep = (size_t)HALF * K * 2;
    const size_t tstep = 2 * hstep;
    const unsigned ldsw = (unsigned)wid * 1024u;
    const int aoff = lds_byte(wr * 64 + fr, fq * 8), boff = lds_byte(wc * 32 + fr, fq * 8);
#define PG8_SA(b, h) (((b) * 2 + (h)) * HTB)
#define PG8_SB(b, h) ((4 + (b) * 2 + (h)) * HTB)
#define PG8_STAGE(bufoff, gbase, voff) do { _Pragma("unroll") for (int _i = 0; _i < 2; ++_i) \
        __builtin_amdgcn_global_load_lds((const unsigned*)((const char*)(gbase) + (voff)[_i]), (PG8_LAS unsigned*)(lds + (bufoff) + ldsw + _i * 8192), 16, 0, 0); } while (0)
#define PG8_STAGE_A(bufoff, ap, h, offs) do { if constexpr (GATHER) { PG8_STAGE(bufoff, ap, offs[h]); } else { PG8_STAGE(bufoff, (ap) + (h) * hstep, voffA); } } while (0)
#define PG8_LDA(dst, b, h) do { _Pragma("unroll") for (int m = 0; m < 4; ++m) _Pragma("unroll") for (int k = 0; k < 2; ++k) dst[m][k] = *(const PG8_LAS bf16x8*)(lds + PG8_SA(b, h) + aoff + m * 2048 + k * 1024); } while (0)
#define PG8_LDB(dst, b, h) do { _Pragma("unroll") for (int n = 0; n < 2; ++n) _Pragma("unroll") for (int k = 0; k < 2; ++k) dst[n][k] = *(const PG8_LAS bf16x8*)(lds + PG8_SB(b, h) + boff + n * 2048 + k * 1024); } while (0)
#define PG8_MMA(ai, bj, At, Bt) do { __builtin_amdgcn_s_setprio(1); _Pragma("unroll") for (int m = 0; m < 4; ++m) _Pragma("unroll") for (int n = 0; n < 2; ++n) _Pragma("unroll") for (int k = 0; k < 2; ++k) \
        acc[ai][bj][m][n] = __builtin_amdgcn_mfma_f32_16x16x32_bf16(Bt[n][k], At[m][k], acc[ai][bj][m][n], 0, 0, 0); __builtin_amdgcn_s_setprio(0); } while (0)
#define PG8_WAIT_V(n) asm volatile("s_waitcnt vmcnt(" #n ")" ::: "memory")
#define PG8_WAIT_L(n) asm volatile("s_waitcnt lgkmcnt(" #n ")" ::: "memory")
#define PG8_BAR __builtin_amdgcn_s_barrier()
#define PG8_SCHED __builtin_amdgcn_sched_barrier(0)
#define PG8_GOFFS(u_, v_) do { if constexpr (GATHER) { _Pragma("unroll") for (int h_ = 0; h_ < 2; ++h_) _Pragma("unroll") for (int i_ = 0; i_ < 2; ++i_) \
        v_[h_][i_] = (unsigned)(S.row_token(u_, h_ * HALF + RA[i_]) * K + CA[i_]) * 2u; } } while (0)
    Unit cur, nxt; int ui = 0;
    if (!S.next(0, cur)) return;
    f32x4 acc[2][2][4][2];
#pragma unroll
    for (int a = 0; a < 2; ++a)
#pragma unroll
        for (int b = 0; b < 2; ++b)
#pragma unroll
            for (int m = 0; m < 4; ++m)
#pragma unroll
                for (int n = 0; n < 2; ++n) acc[a][b][m][n] = (f32x4){0.f, 0.f, 0.f, 0.f};
    bf16x8 At[4][2], B0[2][2], B1[2][2];
    unsigned vA[2][2] = {{0u, 0u}, {0u, 0u}}, nvA[2][2] = {{0u, 0u}, {0u, 0u}};
    PG8_GOFFS(cur, vA);
    const char* cA = GATHER ? (const char*)g.A : (const char*)g.A + (size_t)cur.pm * tstep; const char* cB = (const char*)g.Bt + (size_t)cur.pn * tstep;
    PG8_STAGE(PG8_SB(0, 0), cB, voffB); PG8_STAGE(PG8_SB(0, 1), cB + hstep, voffB); PG8_STAGE_A(PG8_SA(0, 0), cA, 0, vA); PG8_STAGE_A(PG8_SA(0, 1), cA, 1, vA);
    if (wr == 1) PG8_BAR;
    PG8_WAIT_V(2); PG8_BAR;
    PG8_STAGE(PG8_SB(1, 0), cB + kstep, voffB); PG8_STAGE_A(PG8_SA(1, 0), cA + kstep, 0, vA); PG8_STAGE(PG8_SB(1, 1), cB + hstep + kstep, voffB);
    PG8_WAIT_V(6); PG8_BAR;
    for (;;) {
        const bool has_next = S.next(ui + 1, nxt);
        if (has_next) { PG8_GOFFS(nxt, nvA); } else { if constexpr (GATHER) {
#pragma unroll
            for (int h_ = 0; h_ < 2; ++h_)
#pragma unroll
                for (int i_ = 0; i_ < 2; ++i_) nvA[h_][i_] = vA[h_][i_]; } }
        const char* nA = GATHER ? cA : (has_next ? (const char*)g.A + (size_t)nxt.pm * tstep : cA); const char* nB = has_next ? (const char*)g.Bt + (size_t)nxt.pn * tstep : cB;
#pragma unroll 1
        for (int t = 0; t < nt; t += 2) {
            const bool last = (t == nt - 2);
            const char* a1 = cA + (size_t)(t + 1) * kstep;
            const char* a2 = last ? nA : cA + (size_t)(t + 2) * kstep; const char* b2 = last ? nB : cB + (size_t)(t + 2) * kstep;
            const char* a3 = a2 + kstep; const char* b3 = b2 + kstep;
            unsigned sA[2][2];
#pragma unroll
            for (int h_ = 0; h_ < 2; ++h_)
#pragma unroll
                for (int i_ = 0; i_ < 2; ++i_) sA[h_][i_] = last ? nvA[h_][i_] : vA[h_][i_];
            PG8_LDB(B0, 0, 0); PG8_LDB(B1, 0, 1); PG8_SCHED; PG8_LDA(At, 0, 0); PG8_STAGE_A(PG8_SA(1, 1), a1, 1, vA);
            PG8_WAIT_V(8); PG8_WAIT_L(0); PG8_BAR; PG8_MMA(0, 0, At, B0); PG8_MMA(0, 1, At, B1); PG8_BAR; PG8_SCHED;
            PG8_LDA(At, 0, 1); PG8_STAGE(PG8_SB(0, 0), b2, voffB); PG8_STAGE(PG8_SB(0, 1), b2 + hstep, voffB); PG8_STAGE_A(PG8_SA(0, 0), a2, 0, sA);
            PG8_WAIT_V(8); PG8_WAIT_L(0); PG8_BAR; PG8_MMA(1, 0, At, B0); PG8_MMA(1, 1, At, B1); PG8_BAR; PG8_SCHED;
            PG8_LDB(B0, 1, 0); PG8_LDB(B1, 1, 1); PG8_SCHED; PG8_LDA(At, 1, 0); PG8_STAGE_A(PG8_SA(0, 1), a2, 1, sA);
            PG8_WAIT_V(8); PG8_WAIT_L(0); PG8_BAR; PG8_MMA(0, 0, At, B0); PG8_MMA(0, 1, At, B1); PG8_BAR; PG8_SCHED;
            PG8_LDA(At, 1, 1); PG8_STAGE(PG8_SB(1, 0), b3, voffB); PG8_STAGE(PG8_SB(1, 1), b3 + hstep, voffB); PG8_STAGE_A(PG8_SA(1, 0), a3, 0, sA);
            PG8_WAIT_V(8); PG8_WAIT_L(0); PG8_BAR; PG8_MMA(1, 0, At, B0); PG8_MMA(1, 1, At, B1); PG8_BAR; PG8_SCHED;
        }
        if (wr == 0) PG8_BAR;
        E(acc, cur, wr, wc, fr, fq);
        if (!has_next) break;
#pragma unroll
        for (int a = 0; a < 2; ++a)
#pragma unroll
            for (int b = 0; b < 2; ++b)
#pragma unroll
                for (int m = 0; m < 4; ++m)
#pragma unroll
                    for (int n = 0; n < 2; ++n) acc[a][b][m][n] = (f32x4){0.f, 0.f, 0.f, 0.f};
        cur = nxt; cA = nA; cB = nB; ++ui;
#pragma unroll
        for (int h_ = 0; h_ < 2; ++h_)
#pragma unroll
            for (int i_ = 0; i_ < 2; ++i_) vA[h_][i_] = nvA[h_][i_];
        if (wr == 1) PG8_BAR;
    }
    PG8_WAIT_V(0);
    PG8_BAR;
#undef PG8_SA
#undef PG8_SB
#undef PG8_STAGE
#undef PG8_STAGE_A
#undef PG8_LDA
#undef PG8_LDB
#undef PG8_MMA
#undef PG8_WAIT_V
#undef PG8_WAIT_L
#undef PG8_BAR
#undef PG8_SCHED
#undef PG8_GOFFS
}
}
namespace epi {
using pg8::Unit;
__device__ __forceinline__ u32x4 pack8(f32x4 v0, f32x4 v1) { u32x4 w; w.x = cvt_pk_bf16(v0[0], v0[1]); w.y = cvt_pk_bf16(v0[2], v0[3]); w.z = cvt_pk_bf16(v1[0], v1[1]); w.w = cvt_pk_bf16(v1[2], v1[3]); return w; }

struct EpiQKV {
    static constexpr bool PERM = true;
    bf16_t* O; const float* rstd; float* nrm;
    __device__ __forceinline__ void operator()(const f32x4 (&acc)[2][2][4][2], const Unit& u, int wr, int wc, int fr, int fq) const {
        const int t = u.pn >> 1, cin = (u.pn & 1) * 256 + wc * 32 + 8 * fq;
        bf16_t* base = O + (size_t)t * ((size_t)M * DH);
        const float sc = (t == 0 || t == 3) ? C2 : 1.f;
        const bool do_n = (t == 3 || t == 4);
        const int row0 = u.pm * 256 + wr * 64 + fr;
        float mx[2][2] = {{0.f, 0.f}, {0.f, 0.f}};
#pragma unroll
        for (int ai = 0; ai < 2; ++ai)
#pragma unroll
            for (int m = 0; m < 4; ++m) { const int r = row0 + ai * 128 + m * 16; const float rs = rstd[r] * sc; bf16_t* rowp = base + (size_t)r * DH + cin;
#pragma unroll
                for (int bj = 0; bj < 2; ++bj) { const f32x4 v0 = acc[ai][bj][m][0] * rs, v1 = acc[ai][bj][m][1] * rs;
                    *(u32x4*)(rowp + bj * 128) = pack8(v0, v1);
                    if (do_n) { float s = (v0[0] * v0[0] + v0[1] * v0[1]) + (v0[2] * v0[2] + v0[3] * v0[3]) + (v1[0] * v1[0] + v1[1] * v1[1]) + (v1[2] * v1[2] + v1[3] * v1[3]);
                        s += __shfl_xor(s, 16); s += __shfl_xor(s, 32); mx[ai][bj] = fmaxf(mx[ai][bj], s); } } }
        if (do_n) {
#pragma unroll
            for (int ai = 0; ai < 2; ++ai)
#pragma unroll
                for (int bj = 0; bj < 2; ++bj) { float v = mx[ai][bj];
                    v = fmaxf(v, __shfl_xor(v, 1)); v = fmaxf(v, __shfl_xor(v, 2)); v = fmaxf(v, __shfl_xor(v, 4)); v = fmaxf(v, __shfl_xor(v, 8));
                    const int tile64 = u.pm * 4 + ai * 2 + wr, head = (u.pn & 1) * 4 + 2 * bj + (wc >> 1);
                    if ((threadIdx.x & 63) == 0) nrm[(((size_t)(t - 3) * (M / 64) + tile64) * NH + head) * 2 + (wc & 1)] = v; }
        }
    }
};

struct EpiRes {
    static constexpr bool PERM = true;
    const float* x; bf16_t* x1b;
    __device__ __forceinline__ void operator()(const f32x4 (&acc)[2][2][4][2], const Unit& u, int wr, int wc, int fr, int fq) const {
        const int row0 = u.pm * 256 + wr * 64 + fr, col0 = u.pn * 256 + wc * 32 + 8 * fq;
#pragma unroll
        for (int ai = 0; ai < 2; ++ai)
#pragma unroll
            for (int m = 0; m < 4; ++m) { const size_t off = (size_t)(row0 + ai * 128 + m * 16) * D + col0;
#pragma unroll
                for (int bj = 0; bj < 2; ++bj) { const f32x4 x0 = *(const f32x4*)(x + off + bj * 128), x1 = *(const f32x4*)(x + off + bj * 128 + 4);
                    *(u32x4*)(x1b + off + bj * 128) = pack8(acc[ai][bj][m][0] + x0, acc[ai][bj][m][1] + x1); } if (m & 1) asm volatile("" ::: "memory"); }
    }
};

struct EpiGU {
    static constexpr bool PERM = true;
    bf16_t* H; const float* list_rs; const LAS int* cnt;
    __device__ __forceinline__ void operator()(const f32x4 (&acc)[2][2][4][2], const Unit& u, int wr, int wc, int fr, int fq) const {
        const int pn = u.pn & 1, col0 = pn * 128 + wc * 32 + 8 * fq, r0 = wr * 64 + fr, ne = cnt[u.e];
        float rsv[2][4];
#pragma unroll
        for (int ai = 0; ai < 2; ++ai)
#pragma unroll
            for (int m = 0; m < 4; ++m) { int idx = u.ti * 256 + r0 + ai * 128 + m * 16; idx = idx < ne ? idx : 0; rsv[ai][m] = list_rs[(size_t)u.e * CAP + idx]; }
#pragma unroll
        for (int ai = 0; ai < 2; ++ai)
#pragma unroll
            for (int m = 0; m < 4; ++m) { const int r = r0 + ai * 128 + m * 16; const float rs = rsv[ai][m];
                f32x4 hv[2];
#pragma unroll
                for (int n = 0; n < 2; ++n) { const f32x4 gt = acc[ai][0][m][n] * rs, up = acc[ai][1][m][n] * rs;
#pragma unroll
                    for (int q = 0; q < 4; ++q) { const float sg = gt[q] * __builtin_amdgcn_rcpf(1.f + __builtin_amdgcn_exp2f(-gt[q] * LOG2E)); hv[n][q] = sg * up[q]; } }
                *(u32x4*)(H + ((size_t)u.pm * 256 + r) * DE + col0) = pack8(hv[0], hv[1]); }
    }
};

struct EpiDown {
    static constexpr bool PERM = true;
    unsigned char* Y; const int* list_tok; const float* list_w; const LAS int* cnt;
    __device__ __forceinline__ void operator()(const f32x4 (&acc)[2][2][4][2], const Unit& u, int wr, int wc, int fr, int fq) const {
        const int pn = u.pn & 3, col0 = pn * 256 + wc * 64 + 16 * fq, r0 = wr * 64 + fr, ne = cnt[u.e];
        int tsv[2][4]; float wv[2][4];
#pragma unroll
        for (int ai = 0; ai < 2; ++ai)
#pragma unroll
            for (int m = 0; m < 4; ++m) { const int idx = u.ti * 256 + r0 + ai * 128 + m * 16; const int ic = idx < ne ? idx : 0;
                const int t_ = list_tok[(size_t)u.e * CAP + ic]; tsv[ai][m] = (idx < ne) ? t_ : 2 * M; wv[ai][m] = list_w[(size_t)u.e * CAP + ic] * 16.0f; }
#pragma unroll
        for (int ai = 0; ai < 2; ++ai)
#pragma unroll
            for (int m = 0; m < 4; ++m) { const float w = wv[ai][m]; u32x4 o;
#pragma unroll
                for (int bj = 0; bj < 2; ++bj)
#pragma unroll
                    for (int n = 0; n < 2; ++n) { const f32x4 v = acc[ai][bj][m][n] * w; int pk = 0;
                        pk = __builtin_amdgcn_cvt_pk_fp8_f32(v[0], v[1], pk, false); pk = __builtin_amdgcn_cvt_pk_fp8_f32(v[2], v[3], pk, true); o[bj * 2 + n] = (unsigned)pk; }
                *(u32x4*)(Y + (size_t)tsv[ai][m] * D + col0) = o; }
    }
};
}
namespace att {
constexpr int PITCH = DH;
constexpr int NSLOT = 6, SLOTB = 8192, PF = 5;
constexpr int L_K = 0, L_V = NSLOT * SLOTB, L_TAB = 2 * NSLOT * SLOTB;
constexpr int TABN = 336;
constexpr int L_CK = L_TAB + 8192;
constexpr int L_MISC = L_CK + 32768;
constexpr int L_END = L_MISC + 1024;
typedef LAS const char* lds_cptr;
typedef short v4i16_t __attribute__((ext_vector_type(4)));

__device__ const unsigned char BUCKET[3][132] = {
 {0,1,2,3,4,5,6,7,8,9,10,11,12,13,14,15,16,16,16,16,16,16,17,17,17,17,17,17,17,17,18,18,18,18,18,18,18,18,18,18,19,19,19,19,19,19,19,19,19,19,19,19,19,19,20,20,20,20,20,20,20,20,20,20,20,20,20,20,20,20,20,20,20,21,21,21,21,21,21,21,21,21,21,21,21,21,21,21,21,21,21,21,21,21,21,21,21,21,21,22,22,22,22,22,22,22,22,22,22,22,22,22,22,22,22,22,22,22,22,22,22,22,22,22,22,22,22,22,22,0,0,0},
 {0,4,8,12,16,16,17,17,18,18,19,19,19,19,20,20,20,20,20,21,21,21,21,21,21,22,22,22,22,22,22,22,22,22,23,23,23,23,23,23,23,23,23,23,23,23,24,24,24,24,24,24,24,24,24,24,24,24,24,24,24,24,25,25,25,25,25,25,25,25,25,25,25,25,25,25,25,25,25,25,25,25,25,26,26,26,26,26,26,26,26,26,26,26,26,26,26,26,26,26,26,26,26,26,26,26,26,26,26,26,26,26,26,27,27,27,27,27,27,27,27,27,27,27,27,27,27,27,27,0,0,0},
 {0,16,18,19,20,21,21,22,22,23,23,23,24,24,24,24,25,25,25,25,25,26,26,26,26,26,26,26,26,27,27,27,27,27,27,27,27,27,27,28,28,28,28,28,28,28,28,28,28,28,28,28,29,29,29,29,29,29,29,29,29,29,29,29,29,29,29,29,29,29,30,30,30,30,30,30,30,30,30,30,30,30,30,30,30,30,30,30,30,30,30,30,30,30,30,31,31,31,31,31,31,31,31,31,31,31,31,31,31,31,31,31,31,31,31,31,31,31,31,31,31,31,31,31,31,31,31,31,31,0,0,0}};

__device__ __forceinline__ int crow(int r, int hi) { return (r & 3) + 8 * (r >> 2) + 4 * hi; }
__device__ __forceinline__ s16x4 vtr(lds_cptr p) { return __builtin_bit_cast(s16x4, __builtin_amdgcn_ds_read_tr16_b64_v4i16((LAS v4i16_t*)p)); }
__device__ __forceinline__ void glds16(const void* gsrc, unsigned lds_dst) { unsigned keep;
    asm volatile("s_mov_b32 %0, m0\n\ts_mov_b32 m0, %2\n\ts_nop 0\n\tglobal_load_lds_dwordx4 %1, off\n\ts_mov_b32 m0, %0" : "=&s"(keep) : "v"(gsrc), "s"(lds_dst) : "memory"); }
__device__ __forceinline__ void glds4(const void* gsrc, unsigned lds_dst) { unsigned keep;
    asm volatile("s_mov_b32 %0, m0\n\ts_mov_b32 m0, %2\n\ts_nop 0\n\tglobal_load_lds_dword %1, off\n\ts_mov_b32 m0, %0" : "=&s"(keep) : "v"(gsrc), "s"(lds_dst) : "memory"); }
#define ATT_WAIT_BAR(N) asm volatile("s_waitcnt vmcnt(" #N ") lgkmcnt(0)\n\ts_barrier" ::: "memory")

__device__ __forceinline__ float max3f(float a, float b, float c) { float r; asm("v_max3_f32 %0, %1, %2, %3" : "=v"(r) : "v"(a), "v"(b), "v"(c)); return r; }
__device__ __forceinline__ float fadd_s(float a, float b) { float r; asm("v_add_f32_e32 %0, %1, %2" : "=v"(r) : "v"(a), "v"(b)); return r; }
struct WaveState { float mref, l; f32x16 o0, o1, negm; };
__device__ __forceinline__ void ws_reset(WaveState& st) { st.mref = 0.f; st.l = 0.f;
#pragma unroll
    for (int r = 0; r < 16; ++r) { st.o0[r] = 0.f; st.o1[r] = 0.f; st.negm[r] = 0.f; } }

template <bool SUB, int PVT = 0>
__device__ __forceinline__ void tile_compute(lds_cptr kslot, const int (&kofs)[4], lds_cptr vslot, const bf16x8 (&qr)[4], const LAS float* tb, bool band, int qpos, int kpos0,
                                             WaveState& st, int& started, int r32, int hi, int lane) {
    f32x16 p0, p1;
    const lds_cptr vb = vslot + ((lane >> 4) & 1) * 32 + (lane & 3) * 8 + (4 * hi + ((lane & 15) >> 2)) * 64;
    bf16x8 kf[8]; f32x4 tt[8];
#pragma unroll
    for (int d0 = 0; d0 < 4; ++d0) { kf[2 * d0] = *(const LAS bf16x8*)(kslot + kofs[d0]); kf[2 * d0 + 1] = *(const LAS bf16x8*)(kslot + kofs[d0] + 4096); }
#pragma unroll
    for (int g = 0; g < 4; ++g) { tt[2 * g] = *(const LAS f32x4*)(tb + 8 * g + 4 * hi); tt[2 * g + 1] = *(const LAS f32x4*)(tb + 32 + 8 * g + 4 * hi); }
    __builtin_amdgcn_sched_barrier(0);
    p0 = __builtin_amdgcn_mfma_f32_32x32x16_bf16(kf[0], qr[0], st.negm, 0, 0, 0);
    p1 = __builtin_amdgcn_mfma_f32_32x32x16_bf16(kf[1], qr[0], st.negm, 0, 0, 0);
#pragma unroll
    for (int d0 = 1; d0 < 4; ++d0) {
        p0 = __builtin_amdgcn_mfma_f32_32x32x16_bf16(kf[2 * d0], qr[d0], p0, 0, 0, 0);
        p1 = __builtin_amdgcn_mfma_f32_32x32x16_bf16(kf[2 * d0 + 1], qr[d0], p1, 0, 0, 0);
    }
    s16x4 vf[16];
#pragma unroll
    for (int ks = 0; ks < 4; ++ks) { vf[4 * ks] = vtr(vb + ks * 1024); vf[4 * ks + 1] = vtr(vb + ks * 1024 + 512); vf[4 * ks + 2] = vtr(vb + 4096 + ks * 1024); vf[4 * ks + 3] = vtr(vb + 4096 + ks * 1024 + 512); }
    __builtin_amdgcn_sched_barrier(0);
#pragma unroll
    for (int g = 0; g < 4; ++g) {
#pragma unroll
        for (int q = 0; q < 4; ++q) { if (SUB) { p0[4 * g + q] -= tt[2 * g][q]; p1[4 * g + q] -= tt[2 * g + 1][q]; } else { p0[4 * g + q] += tt[2 * g][q]; p1[4 * g + q] += tt[2 * g + 1][q]; } } }
    if (band) {
#pragma unroll
        for (int r = 0; r < 16; ++r) { const int kv = kpos0 + crow(r, hi); if (kv > qpos) p0[r] = NEGBIG; if (kv + 32 > qpos) p1[r] = NEGBIG; }
    }
    float rm, rm2;
    { rm = max3f(p0[0], p0[1], p1[0]); rm2 = max3f(p0[2], p0[3], p1[1]); rm = max3f(rm, p1[2], p1[3]);
#pragma unroll
      for (int r = 4; r < 16; r += 4) { rm = max3f(rm, p0[r], p0[r + 1]); rm2 = max3f(rm2, p0[r + 2], p0[r + 3]); rm = max3f(rm, p1[r], p1[r + 1]); rm2 = max3f(rm2, p1[r + 2], p1[r + 3]); }
      rm = fmaxf(rm, rm2); }
    { auto rr = __builtin_amdgcn_permlane32_swap(__float_as_uint(rm), __float_as_uint(rm), false, false); rm = fmaxf(__uint_as_float(rr[0]), __uint_as_float(rr[1])); }
    if (PVT == 3) { st.l += rm; return; }
    if (started && __all(rm < -32.0f)) return;
    started = 1;
    if (__any(rm > 8.0f)) {
        const float dl = fmaxf(rm, 0.f), f = __builtin_amdgcn_exp2f(-dl);
        st.mref += dl; st.l *= f;
#pragma unroll
        for (int r = 0; r < 16; ++r) { p0[r] -= dl; p1[r] -= dl; st.o0[r] *= f; st.o1[r] *= f; st.negm[r] = -st.mref; }
    }
#pragma unroll
    for (int r = 0; r < 16; ++r) { p0[r] = __builtin_amdgcn_exp2f(p0[r]); p1[r] = __builtin_amdgcn_exp2f(p1[r]); }
    { float sa = p0[0], sb = p1[0];
#pragma unroll
      for (int r = 1; r < 16; ++r) { sa += p0[r]; asm volatile("" : "+v"(sa)); sb += p1[r]; asm volatile("" : "+v"(sb)); }
      st.l += sa + sb; }
    u32x4 pw[4];
#pragma unroll
    for (int s = 0; s < 2; ++s)
#pragma unroll
        for (int j = 0; j < 4; ++j) { pw[s][j] = cvt_pk_bf16(p0[8 * s + 2 * j], p0[8 * s + 2 * j + 1]); pw[2 + s][j] = cvt_pk_bf16(p1[8 * s + 2 * j], p1[8 * s + 2 * j + 1]); }
    __builtin_amdgcn_sched_barrier(0);
#pragma unroll
    for (int ks = 0; ks < 4; ++ks) {
        const s16x4 a_lo = vf[4 * ks], a_hi = vf[4 * ks + 1], b_lo = vf[4 * ks + 2], b_hi = vf[4 * ks + 3];
        const bf16x8 va = (bf16x8){a_lo[0], a_lo[1], a_lo[2], a_lo[3], a_hi[0], a_hi[1], a_hi[2], a_hi[3]};
        const bf16x8 vb2 = (bf16x8){b_lo[0], b_lo[1], b_lo[2], b_lo[3], b_hi[0], b_hi[1], b_hi[2], b_hi[3]};
        const bf16x8 pf = __builtin_bit_cast(bf16x8, pw[ks]);
        st.o0 = __builtin_amdgcn_mfma_f32_32x32x16_bf16(va, pf, st.o0, 0, 0, 0);
        st.o1 = __builtin_amdgcn_mfma_f32_32x32x16_bf16(vb2, pf, st.o1, 0, 0, 0);
    }
}

__device__ __forceinline__ void stage_o(const WaveState& st, float inv_l, LAS char* stg, int r32, int hi) {
#pragma unroll
    for (int g = 0; g < 4; ++g) {
        u32x2 w0, w1;
        w0.x = cvt_pk_bf16(st.o0[4 * g] * inv_l, st.o0[4 * g + 1] * inv_l); w0.y = cvt_pk_bf16(st.o0[4 * g + 2] * inv_l, st.o0[4 * g + 3] * inv_l);
        w1.x = cvt_pk_bf16(st.o1[4 * g] * inv_l, st.o1[4 * g + 1] * inv_l); w1.y = cvt_pk_bf16(st.o1[4 * g + 2] * inv_l, st.o1[4 * g + 3] * inv_l);
        *(LAS u32x2*)(stg + r32 * 128 + ((g ^ (r32 & 7)) * 16) + 8 * hi) = w0;
        *(LAS u32x2*)(stg + r32 * 128 + (((4 + g) ^ (r32 & 7)) * 16) + 8 * hi) = w1;
    }
}

struct Desc { int type, branch, dsh, res, lb, qb, jb, je; };
template <int NP>
__device__ __forceinline__ Desc get_desc(int u, int sub, const LAS int* js) {
    constexpr int DU = 12 / NP, BPB = 4 / NP;
    Desc q;
    if (u < DU) { q.type = 0; q.branch = u / BPB; const int blk = sub * BPB + (u - q.branch * BPB); q.dsh = 2 * q.branch; const int nlb = 32 >> q.dsh; q.res = blk >> (5 - q.dsh); q.lb = blk & (nlb - 1); q.qb = 0; q.jb = q.lb == 0 ? 2 : 0; q.je = 6; }
    else { q.type = 1; q.branch = 0; q.dsh = 0; q.res = 0; q.lb = 0; q.qb = sub + 8 * NP * (u - DU); q.jb = __builtin_amdgcn_readfirstlane(js[u - DU]); q.je = 4 * q.qb + 4; }
    return q;
}
__device__ __forceinline__ void wait_vm_bar(int c) {
    switch (c) { case 1: ATT_WAIT_BAR(1); break; case 2: ATT_WAIT_BAR(2); break; case 3: ATT_WAIT_BAR(3); break; case 4: ATT_WAIT_BAR(4); break; case 5: ATT_WAIT_BAR(5); break; case 6: ATT_WAIT_BAR(6); break; case 7: ATT_WAIT_BAR(7); break; case 8: ATT_WAIT_BAR(8); break; case 9: ATT_WAIT_BAR(9); break; case 10: ATT_WAIT_BAR(10); break; case 11: ATT_WAIT_BAR(11); break; case 12: ATT_WAIT_BAR(12); break; case 13: ATT_WAIT_BAR(13); break; case 14: ATT_WAIT_BAR(14); break; case 15: ATT_WAIT_BAR(15); break; case 16: ATT_WAIT_BAR(16); break; case 17: ATT_WAIT_BAR(17); break; case 18: ATT_WAIT_BAR(18); break; case 19: ATT_WAIT_BAR(19); break; case 20: ATT_WAIT_BAR(20); break; case 21: ATT_WAIT_BAR(21); break; case 22: ATT_WAIT_BAR(22); break; case 23: ATT_WAIT_BAR(23); break; case 24: ATT_WAIT_BAR(24); break; case 25: ATT_WAIT_BAR(25); break; case 26: ATT_WAIT_BAR(26); break; case 27: ATT_WAIT_BAR(27); break; case 28: ATT_WAIT_BAR(28); break; case 29: ATT_WAIT_BAR(29); break; case 30: ATT_WAIT_BAR(30); break; default: ATT_WAIT_BAR(0); break; }
}
__device__ __forceinline__ void wait_vm(int c) {
    switch (c) { case 1: asm volatile("s_waitcnt vmcnt(1)" ::: "memory"); break; case 2: asm volatile("s_waitcnt vmcnt(2)" ::: "memory"); break; case 3: asm volatile("s_waitcnt vmcnt(3)" ::: "memory"); break; case 4: asm volatile("s_waitcnt vmcnt(4)" ::: "memory"); break; case 5: asm volatile("s_waitcnt vmcnt(5)" ::: "memory"); break; case 6: asm volatile("s_waitcnt vmcnt(6)" ::: "memory"); break; case 7: asm volatile("s_waitcnt vmcnt(7)" ::: "memory"); break; case 8: asm volatile("s_waitcnt vmcnt(8)" ::: "memory"); break; case 9: asm volatile("s_waitcnt vmcnt(9)" ::: "memory"); break; case 10: asm volatile("s_waitcnt vmcnt(10)" ::: "memory"); break; case 11: asm volatile("s_waitcnt vmcnt(11)" ::: "memory"); break; case 12: asm volatile("s_waitcnt vmcnt(12)" ::: "memory"); break; case 13: asm volatile("s_waitcnt vmcnt(13)" ::: "memory"); break; case 14: asm volatile("s_waitcnt vmcnt(14)" ::: "memory"); break; case 15: asm volatile("s_waitcnt vmcnt(15)" ::: "memory"); break; case 16: asm volatile("s_waitcnt vmcnt(16)" ::: "memory"); break; case 17: asm volatile("s_waitcnt vmcnt(17)" ::: "memory"); break; case 18: asm volatile("s_waitcnt vmcnt(18)" ::: "memory"); break; case 19: asm volatile("s_waitcnt vmcnt(19)" ::: "memory"); break; case 20: asm volatile("s_waitcnt vmcnt(20)" ::: "memory"); break; case 21: asm volatile("s_waitcnt vmcnt(21)" ::: "memory"); break; case 22: asm volatile("s_waitcnt vmcnt(22)" ::: "memory"); break; case 23: asm volatile("s_waitcnt vmcnt(23)" ::: "memory"); break; case 24: asm volatile("s_waitcnt vmcnt(24)" ::: "memory"); break; case 25: asm volatile("s_waitcnt vmcnt(25)" ::: "memory"); break; case 26: asm volatile("s_waitcnt vmcnt(26)" ::: "memory"); break; case 27: asm volatile("s_waitcnt vmcnt(27)" ::: "memory"); break; case 28: asm volatile("s_waitcnt vmcnt(28)" ::: "memory"); break; case 29: asm volatile("s_waitcnt vmcnt(29)" ::: "memory"); break; case 30: asm volatile("s_waitcnt vmcnt(30)" ::: "memory"); break; default: if (c <= 0) asm volatile("s_waitcnt vmcnt(0)" ::: "memory"); else asm volatile("s_waitcnt vmcnt(30)" ::: "memory"); break; }
}
constexpr int L_C = 2 * NSLOT * SLOTB;
constexpr int L_TB3 = L_C + 2048;
constexpr int L_CTL = L_TB3 + 3 * 4 * TABN * 4;
constexpr int L_QS = L_CTL + 256;
constexpr int L_CQ = L_QS + 8 * 4096;

template <int PV, int ONLY, int NP>
__device__ __forceinline__ void attn_phase(int pass, int vcu, const bf16_t* qkv, bf16_t* og, float* lse, bf16_t* of, const float* cf2, const float* nrm, const float* rel_bias, LAS char* lds) {
    const int tid = threadIdx.x, lane = tid & 63, r32 = lane & 31, hi = lane >> 5; const int wid = __builtin_amdgcn_readfirstlane(tid >> 6);
    constexpr int S_ = 8 * NP, DU = 12 / NP, FU = 4 / NP;
    const int u0 = (ONLY == 1) ? DU : 0, u1 = (ONLY == 0) ? DU : DU + FU;
    const int bh = (vcu / S_) * NP + pass, sub = vcu % S_, b = bh >> 3, h = bh & 7;
    const bf16_t* QD = qkv; const bf16_t* KD = qkv + (size_t)1 * M * DH; const bf16_t* VD = qkv + (size_t)2 * M * DH;
    const bf16_t* QF = qkv + (size_t)3 * M * DH; const bf16_t* KF = qkv + (size_t)4 * M * DH; const bf16_t* VF = qkv + (size_t)5 * M * DH;
    const size_t rowb = (size_t)b * T;
    const float* cfh = cf2 + (size_t)bh * T;
    LAS float* tab = (LAS float*)(lds + L_TB3);
    LAS int* js = (LAS int*)(lds + L_CTL);
    const unsigned lds0 = (unsigned)(uintptr_t)lds;
    const int krow_ = 8 * wid + (lane >> 3), kch_ = (lane & 7) ^ ((krow_ >> 1) & 7);
    int kofs[4];
#pragma unroll
    for (int d0 = 0; d0 < 4; ++d0) kofs[d0] = r32 * 128 + (((2 * d0 + hi) ^ ((r32 >> 1) & 7)) * 16);
    if (ONLY != 1) { LAS float* rbh = (LAS float*)(lds + L_QS);
      if (tid < 32) rbh[tid] = rel_bias[tid * NH + h] * LOG2E;
      asm volatile("s_waitcnt vmcnt(0) lgkmcnt(0)" ::: "memory"); __builtin_amdgcn_s_barrier(); asm volatile("" ::: "memory");
      for (int idx = tid; idx < 3 * 4 * TABN; idx += 512) { const int br = idx / (4 * TABN), rem = idx - br * 4 * TABN, s = rem / TABN, u = rem - s * TABN, mm = 255 - (u + s);
        float v = NEGBIG; if (mm >= 0 && mm <= 128) v = rbh[(int)BUCKET[br][mm]];
        tab[idx] = v; } }
    if (ONLY != 0 && wid < FU) {
        const int qb = sub + 8 * NP * wid, jd = 4 * qb;
        const float* nq = nrm + ((size_t)0 * (M / 64) + (size_t)b * 128) * NH * 2;
        const float* nk = nrm + ((size_t)1 * (M / 64) + (size_t)b * 128) * NH * 2;
        float qm = 0.f, km = 0.f;
#pragma unroll
        for (int i = 0; i < 4; ++i) { const float* a = nq + ((size_t)(jd + i) * NH + h) * 2; const float* c_ = nk + ((size_t)(jd + i) * NH + h) * 2;
            qm = fmaxf(qm, a[0] + a[1]); km = fmaxf(km, c_[0] + c_[1]); }
        qm = sqrtf(qm); km = sqrtf(km);
        const float c_t0 = cfh[256 * qb];
        int jmin = jd;
#pragma unroll
        for (int half = 0; half < 2; ++half) { const int j = lane + 64 * half; bool keep = false;
            if (j < jd) { const float c_e = cfh[64 * j + 63]; const float* c_ = nk + ((size_t)j * NH + h) * 2; const float kn = sqrtf(c_[0] + c_[1]);
                const float ub = (c_t0 - c_e) + 1.02f * qm * (kn + km);
                keep = !(ub < -32.0f); }
            const unsigned long long bal = __ballot(keep);
            if (bal) { const int f = __ffsll((long long)bal) - 1 + 64 * half; jmin = f < jmin ? f : jmin; } }
        if (lane == 0) js[wid] = jmin;
    }
    asm volatile("s_waitcnt vmcnt(0) lgkmcnt(0)" ::: "memory"); __builtin_amdgcn_s_barrier(); asm volatile("" ::: "memory");
    int total = 0;
#pragma unroll 1
    for (int u = u0; u < u1; ++u) { const Desc q = get_desc<NP>(u, sub, js); total += q.je - q.jb; }
    int iu = u0, nis = 0, isl = 0; Desc iq = get_desc<NP>(u0, sub, js); int ij = iq.jb;
    const bf16_t* kb_; const bf16_t* vb_; const float* cb_; long tstr;
#define SET_ISSUE() do { if (iq.type == 0) { const int d_ = (PV == 6) ? 1 : (1 << iq.dsh); const int kl0 = 256 * iq.lb - 128; \
            kb_ = KD + (rowb + (long)(kl0 + krow_) * d_ + iq.res) * PITCH + h * HD + kch_ * 8; \
            vb_ = VD + (rowb + (long)(kl0 + 16 * (wid & 3) + (lane >> 2)) * d_ + iq.res) * PITCH + h * HD + (wid >> 2) * 32 + (lane & 3) * 8; \
            cb_ = cfh + lane; tstr = (long)64 * d_ * PITCH; } \
        else { kb_ = KF + (rowb + krow_) * PITCH + h * HD + kch_ * 8; vb_ = VF + (rowb + 16 * (wid & 3) + (lane >> 2)) * PITCH + h * HD + (wid >> 2) * 32 + (lane & 3) * 8; \
            cb_ = cfh + lane; tstr = (long)64 * PITCH; } } while (0)
#define ISSUE() do { if (iu < u1) { const int sl_ = isl; const int aj_ = iq.type ? (iq.je - 1 - (ij - iq.jb)) : ij; \
            glds16(kb_ + (long)aj_ * tstr, (unsigned)__builtin_amdgcn_readfirstlane(lds0 + L_K + sl_ * SLOTB + wid * 1024)); \
            glds16(vb_ + (long)aj_ * tstr, (unsigned)__builtin_amdgcn_readfirstlane(lds0 + L_V + sl_ * SLOTB + wid * 1024)); \
            glds4(cb_ + (iq.type ? 64 * aj_ : 0), (unsigned)__builtin_amdgcn_readfirstlane(lds0 + L_C + sl_ * 256)); \
            ++nis; isl = (isl == NSLOT - 1) ? 0 : isl + 1; ++ij; if (ij == iq.je) { ++iu; if (iu < u1) { iq = get_desc<NP>(iu, sub, js); ij = iq.jb; SET_ISSUE(); } } } } while (0)
    SET_ISSUE();
    int cu = u0; Desc cq_ = get_desc<NP>(u0, sub, js); int cj = cq_.jb;
#define QDMA(dq) do { const int rq_ = (dq.type == 0) ? ((256 * dq.lb + 32 * wid + r32) << dq.dsh) + dq.res : 256 * dq.qb + 32 * wid + r32; \
        const bf16_t* qrow_ = (dq.type == 0 ? QD : QF) + (rowb + rq_) * PITCH + h * HD + hi * 8; \
        _Pragma("unroll") for (int d0 = 0; d0 < 4; ++d0) glds16(qrow_ + d0 * 16, (unsigned)__builtin_amdgcn_readfirstlane(lds0 + L_QS + wid * 4096 + d0 * 1024)); \
        glds4(cfh + (dq.type ? rq_ : r32), (unsigned)__builtin_amdgcn_readfirstlane(lds0 + L_CQ + wid * 256)); } while (0)
#define QREAD(dq) do { _Pragma("unroll") for (int d0 = 0; d0 < 4; ++d0) qr[d0] = *(const LAS bf16x8*)(lds + L_QS + wid * 4096 + d0 * 1024 + lane * 16); \
        } while (0)
    bf16x8 qr[4];
    QDMA(cq_);
    asm volatile("s_waitcnt vmcnt(0)" ::: "memory");
    QREAD(cq_);
    asm volatile("s_waitcnt lgkmcnt(0)" ::: "memory");
    ISSUE(); ISSUE(); ISSUE(); ISSUE(); ISSUE();
    WaveState st; ws_reset(st); int started = 0;
    int extra = 0, qsteps = 0, csl = 0, nis_q = 0;
#pragma unroll 1
    for (int n = 0; n < total; ++n) {
        const int ahead = nis - 1 - n;
        if (PV < 2) { wait_vm_bar(3 * ahead + extra + (qsteps > 0 ? 5 : 0)); extra = 0; if (qsteps > 0) --qsteps;
        ISSUE(); } else { ATT_WAIT_BAR(0); if (iu < u1) { ++nis; isl = (isl == NSLOT - 1) ? 0 : isl + 1; ++ij; if (ij == iq.je) { ++iu; if (iu < u1) { iq = get_desc<NP>(iu, sub, js); ij = iq.jb; } } } }
        const bool lastt = (cj == cq_.je - 1);
        if (cj == cq_.jb && cu + 1 < u1) { const Desc nq_ = get_desc<NP>(cu + 1, sub, js); QDMA(nq_); qsteps = PF; nis_q = nis; }
        const int sl = csl; csl = (csl == NSLOT - 1) ? 0 : csl + 1;
        const int aj = cq_.type ? (cq_.je - 1 - (cj - cq_.jb)) : cj;
        if (ONLY != 1 && (ONLY == 0 || cq_.type == 0)) {
            const int wlo = wid >> 1;
            if (PV != 1 && PV != 5 && cj >= wlo && cj <= wlo + 2) {
                const int jj = cj - wlo; const int z0 = 127 - 32 * (wid & 1) - r32 + 64 * jj, s = z0 & 3;
                const LAS float* tb = tab + (cq_.branch * 4 + s) * TABN + (z0 - s);
                tile_compute<false, PV>((lds_cptr)(lds + L_K + sl * SLOTB), kofs, (lds_cptr)(lds + L_V + sl * SLOTB), qr, tb, false, 0, 0, st, started, r32, hi, lane);
            }
        } else if (ONLY != 0) {
            const int qfirst = 256 * cq_.qb + 32 * wid;
            if (PV != 1 && PV != 5 && 64 * aj <= qfirst + 31) {
                const bool band = (64 * aj + 63 > qfirst);
                tile_compute<true, PV>((lds_cptr)(lds + L_K + sl * SLOTB), kofs, (lds_cptr)(lds + L_V + sl * SLOTB), qr, (const LAS float*)(lds + L_C + sl * 256), band, qfirst + r32, 64 * aj, st, started, r32, hi, lane);
            }
        }
        ++cj;
        if (lastt) {
            float lt = st.l; { auto rr = __builtin_amdgcn_permlane32_swap(__float_as_uint(lt), __float_as_uint(lt), false, false); lt = __uint_as_float(rr[0]) + __uint_as_float(rr[1]); }
            const Desc od = cq_;
            ++cu;
            if (cu < u1) { cq_ = get_desc<NP>(cu, sub, js); cj = cq_.jb;
                wait_vm(3 * (nis - nis_q));
                QREAD(cq_); }
            asm volatile("s_waitcnt lgkmcnt(0)" ::: "memory");
            LAS char* stg = lds + L_QS + wid * 4096;
            stage_o(st, 1.0f / lt, stg, r32, hi);
            asm volatile("s_waitcnt lgkmcnt(0)" ::: "memory");
            { const int rsub = lane >> 3, c16 = lane & 7;
#pragma unroll
              for (int i = 0; i < 4; ++i) { const int rw = i * 8 + rsub; const u32x4 v = *(const LAS u32x4*)(stg + rw * 128 + ((c16 ^ (rw & 7)) * 16));
                if (od.type == 0) { const size_t orow = rowb + (((size_t)(256 * od.lb + 32 * wid + rw)) << od.dsh) + od.res; *(u32x4*)(og + ((size_t)od.branch * M + orow) * PITCH + h * HD + c16 * 8) = v; }
                else { *(u32x4*)(of + (rowb + 256 * od.qb + 32 * wid + rw) * PITCH + h * HD + c16 * 8) = v; } } }
            if (od.type == 0) { const size_t orow = rowb + (((size_t)(256 * od.lb + 32 * wid + r32)) << od.dsh) + od.res;
                if (hi == 0) lse[((size_t)od.branch * M + orow) * NH + h] = st.mref + __builtin_amdgcn_logf(lt);
                extra = 5; } else { extra = 4; }
            asm volatile("s_waitcnt lgkmcnt(0)" ::: "memory");
            ws_reset(st); started = 0;
        }
    }
#undef SET_ISSUE
#undef ISSUE
#undef QDMA
#undef QREAD
    asm volatile("s_waitcnt vmcnt(0) lgkmcnt(0)\n\ts_barrier" ::: "memory");
}
}
constexpr int NWAVES = 8;
constexpr size_t MiB = 1u << 20;
constexpr size_t WS_CTL = 0, CTL_ZERO_BYTES = 1 * MiB;
constexpr size_t WS_RSTD1 = 1 * MiB;
constexpr size_t WS_CTOT = WS_RSTD1 + 128 * 1024;
constexpr size_t WS_NRM = WS_CTOT + 8 * 1024;
constexpr size_t WS_WR = WS_NRM + 64 * 1024;
constexpr size_t WS_CL = 2 * MiB;
constexpr size_t WS_LSE = 3 * MiB;
constexpr size_t WS_WIN = 6 * MiB;
constexpr size_t WS_WOUT = 12 * MiB;
constexpr size_t WS_WGU = 14 * MiB;
constexpr size_t WS_WD = 46 * MiB;
constexpr size_t WS_LTOK = 62 * MiB, WS_LW = 66 * MiB, WS_LRS = 70 * MiB;
constexpr size_t WS_CF2 = 74 * MiB;
constexpr size_t WS_XB = 76 * MiB;
constexpr size_t WS_QKV = 140 * MiB;
constexpr size_t WS_OG = 332 * MiB;
constexpr size_t WS_OF = 428 * MiB;
constexpr size_t WS_H = 332 * MiB;
constexpr size_t WS_X1B = 370 * MiB;
constexpr size_t WS_END = 460 * MiB;
constexpr int CW_BAR = 4096;
constexpr int CW_ECNT = 16384;

constexpr int RING_BYTES = 131072;
constexpr int MISC_OFF = 163840 - 2048;
constexpr int LDS_BYTES = 163840;

#define RLX_AGENT __ATOMIC_RELAXED, __HIP_MEMORY_SCOPE_AGENT

#define XB_TMO      128
#define XB_XCNT(j)  (256  + 64 * (j))
#define XB_XSUB(j)  (1280 + 64 * (j))
#define XB_XGEN(j)  (2304 + 64 * (j))
#define XB_TOP      3328
#define XB_TOPGEN   3392
#define XCD_BAR_WORDS 3456
#define XB_SPIN_CAP (1u << 18)
__device__ __forceinline__ unsigned xb_ld(unsigned* p)              { return __hip_atomic_load(p, __ATOMIC_RELAXED, __HIP_MEMORY_SCOPE_AGENT); }
__device__ __forceinline__ unsigned xb_add(unsigned* p, unsigned v) { return __hip_atomic_fetch_add(p, v, __ATOMIC_RELAXED, __HIP_MEMORY_SCOPE_AGENT); }
__device__ __forceinline__ unsigned xb_xcc_id() { return (unsigned)__builtin_amdgcn_s_getreg((3 << 11) | 20) & 0xFu; }
#define XB_SPIN(cond, bar) do { unsigned _sp = 0; while (cond) { __builtin_amdgcn_s_sleep(1); \
    if ((++_sp & 255u) == 0u) { if (xb_ld(&(bar)[XB_TMO])) break; if (_sp > XB_SPIN_CAP) { atomicAdd(&(bar)[XB_TMO], 1u); break; } } } } while (0)
struct XcdBarrier { unsigned* bar; unsigned x; volatile LAS unsigned* st; };
__device__ __forceinline__ XcdBarrier xcd_barrier_post(unsigned* bar, volatile LAS unsigned* st) {
    XcdBarrier b; b.bar = bar; b.x = xb_xcc_id(); b.st = st;
    if (threadIdx.x == 0) (void)xb_add(&bar[XB_XCNT(b.x)], 1u);
    return b;
}
__device__ __forceinline__ void xcd_barrier_complete(unsigned* bar, unsigned x, unsigned& nloc, unsigned& nx) {
    const unsigned G = gridDim.x * gridDim.y * gridDim.z;
    unsigned sum, cnt, mine, sp = 0u;
    for (;;) {
        sum = 0u; cnt = 0u; mine = 0u;
#pragma unroll
        for (unsigned j = 0; j < 16; ++j) { const unsigned c = xb_ld(&bar[XB_XCNT(j)]); sum += c; cnt += (c > 0u) ? 1u : 0u; mine = (j == x) ? c : mine; }
        if (sum == G) break;
        __builtin_amdgcn_s_sleep(1);
        if ((++sp & 255u) == 0u) { if (xb_ld(&bar[XB_TMO])) break; if (sp > XB_SPIN_CAP) { atomicAdd(&bar[XB_TMO], 1u); break; } }
    }
    nloc = mine > 0u ? mine : 1u; nx = cnt > 0u ? cnt : 1u;
}
__device__ __forceinline__ void xcd_barrier(const XcdBarrier& b) {
    asm volatile("s_waitcnt vmcnt(0)" ::: "memory");
    __syncthreads();
    if (threadIdx.x == 0) {
        unsigned* bar = b.bar;
        __builtin_amdgcn_s_waitcnt(0);
        unsigned nloc = b.st[0], nx = b.st[1];
        if (nloc == 0u) { xcd_barrier_complete(bar, b.x, nloc, nx); b.st[0] = nloc; b.st[1] = nx; }
        const unsigned old = xb_add(&bar[XB_XSUB(b.x)], 1u);
        const unsigned gen = old / nloc;
        if (old + 1u == (gen + 1u) * nloc) {
            __builtin_amdgcn_fence(__ATOMIC_RELEASE, "agent");
            asm volatile("s_waitcnt vmcnt(0)" ::: "memory");
            const unsigned og = xb_add(&bar[XB_TOP], 1u);
            const unsigned tg = og / nx;
            if (og + 1u == (tg + 1u) * nx) xb_add(&bar[XB_TOPGEN], 1u);
            else XB_SPIN(xb_ld(&bar[XB_TOPGEN]) == tg, bar);
            __builtin_amdgcn_fence(__ATOMIC_ACQUIRE, "agent");
            xb_add(&bar[XB_XGEN(b.x)], 1u);
            asm volatile("s_waitcnt vmcnt(0)" ::: "memory");
        } else {
            XB_SPIN(xb_ld(&bar[XB_XGEN(b.x)]) == gen, bar);
            __builtin_amdgcn_fence(__ATOMIC_ACQUIRE, "agent");
            asm volatile("s_waitcnt vmcnt(0)" ::: "memory");
        }
    }
    __syncthreads();
}

__device__ __forceinline__ float wave_sum(float v) {
#pragma unroll
    for (int o = 1; o < 64; o <<= 1) v += __shfl_xor(v, o);
    return v;
}

struct TItem { const float* Wc; const float* gain; bf16_t* WT; int ldn, k0, ldk, dest_row0, mode; };
__device__ __forceinline__ void p0_titem_load(const TItem& t, float (&v)[32], int lane) {
    const float* src = t.Wc + (size_t)(t.k0 + (lane >> 5)) * t.ldn + (lane & 31);
#pragma unroll
    for (int i = 0; i < 32; ++i) v[i] = src[(size_t)(2 * i) * t.ldn];
}
__device__ __forceinline__ void p0_titem_store(const TItem& t, float (&v)[32], LAS float* scr, int lane) {
    if (t.gain) {
#pragma unroll
        for (int i = 0; i < 32; ++i) v[i] *= t.gain[t.k0 + 2 * i + (lane >> 5)]; }
#pragma unroll
    for (int i = 0; i < 32; ++i) scr[(2 * i + (lane >> 5)) * 33 + (lane & 31)] = v[i];
    asm volatile("s_waitcnt lgkmcnt(0)" ::: "memory");
    const int c = lane & 7;
#pragma unroll
    for (int j = 0; j < 4; ++j) { const int n = (lane >> 3) + 8 * j; const LAS float* s = scr + (8 * c) * 33 + n;
        u32x4 o; o.x = cvt_pk_bf16(s[0 * 33], s[1 * 33]); o.y = cvt_pk_bf16(s[2 * 33], s[3 * 33]); o.z = cvt_pk_bf16(s[4 * 33], s[5 * 33]); o.w = cvt_pk_bf16(s[6 * 33], s[7 * 33]);
        int drow = t.dest_row0 + n; if (t.mode == 1) { const int oc = drow; drow = (oc & ~255) + 128 * ((oc >> 3) & 1) + 32 * ((oc >> 6) & 3) + 8 * ((oc >> 4) & 3) + (oc & 7); }
        *(u32x4*)(t.WT + (size_t)drow * t.ldk + t.k0 + 8 * c) = o; }
    asm volatile("s_waitcnt lgkmcnt(0)" ::: "memory");
}

struct Args { const float* in[17]; float* out; unsigned char* ws; int ph_lo, ph_hi; };

#ifndef MK_SKIP_MOE
#define MK_SKIP_MOE 0
#endif
constexpr int N_PHASES = 9;

__global__ void __launch_bounds__(NWAVES * 64, 2) hymba_fwd(Args args) {
    extern __shared__ __attribute__((aligned(16))) unsigned char lds_raw[];
    LAS unsigned char* lds = (LAS unsigned char*)lds_raw;
    const int tid = threadIdx.x, lane = tid & 63; const int wave = __builtin_amdgcn_readfirstlane(tid >> 6);
    const int G = gridDim.x; const int bx = blockIdx.x; const int vcu = (G % 8 == 0) ? (bx % 8) * (G / 8) + bx / 8 : bx;
    unsigned char* ws = args.ws;
    unsigned* ctl = (unsigned*)(ws + WS_CTL);
    const float* x = args.in[0]; const float* w_in = args.in[1]; const float* b_forget = args.in[2]; const float* attn_norm = args.in[3];
    const float* on_dil = args.in[4]; const float* on_fox = args.in[5]; const float* w_out = args.in[6]; const float* ffn_norm = args.in[7];
    const float* w_rg = args.in[8]; const float* b_rg = args.in[9]; const float* w_re = args.in[10]; const float* b_re = args.in[11];
    const float* w_gate = args.in[12]; const float* w_up = args.in[13]; const float* w_down = args.in[14]; const float* rel_bias = args.in[15]; const float* final_norm = args.in[16];
    float* rstd1 = (float*)(ws + WS_RSTD1); float* ctot = (float*)(ws + WS_CTOT); float* nrm = (float*)(ws + WS_NRM); bf16_t* WrT = (bf16_t*)(ws + WS_WR);
    float* cl = (float*)(ws + WS_CL); float* lse = (float*)(ws + WS_LSE); float* cf2 = (float*)(ws + WS_CF2);
    bf16_t* WinT = (bf16_t*)(ws + WS_WIN); bf16_t* WoutT = (bf16_t*)(ws + WS_WOUT); bf16_t* WguT = (bf16_t*)(ws + WS_WGU); bf16_t* WdT = (bf16_t*)(ws + WS_WD);
    int* list_tok = (int*)(ws + WS_LTOK); float* list_w = (float*)(ws + WS_LW); float* list_rs = (float*)(ws + WS_LRS);
    bf16_t* xb = (bf16_t*)(ws + WS_XB); bf16_t* On = (bf16_t*)(ws + WS_XB);
    bf16_t* qkv = (bf16_t*)(ws + WS_QKV); unsigned char* yslot = (unsigned char*)(ws + WS_QKV);
    bf16_t* og = (bf16_t*)(ws + WS_OG); bf16_t* of = (bf16_t*)(ws + WS_OF); bf16_t* Hb = (bf16_t*)(ws + WS_H); bf16_t* x1b = (bf16_t*)(ws + WS_X1B);

    for (int u = tid; u < (LDS_BYTES - MISC_OFF) / 4; u += NWAVES * 64) ((LAS unsigned*)(lds + MISC_OFF))[u] = 0u;
    __syncthreads();
    const int lo = args.ph_lo, hi_ph = args.ph_hi;
    const bool one_launch = (hi_ph - lo) > 1;
    XcdBarrier bar; bar.bar = ctl + CW_BAR; bar.x = 0; bar.st = nullptr;
    if (one_launch) bar = xcd_barrier_post(ctl + CW_BAR, (volatile LAS unsigned*)(lds + MISC_OFF));
#ifndef PHASE_MASK
#define PHASE_MASK 0x1ff
#endif
#define IN(k) (((PHASE_MASK >> (k)) & 1) && lo <= (k) && (k) < hi_ph)
#define SEAM(k) do { if (IN(k) && IN((k) + 1)) xcd_barrier(bar); } while (0)

    if (IN(0)) {
        {
        LAS float* scr = (LAS float*)(lds + wave * 8704);
        const int gw = vcu * NWAVES + wave, NGW = G * NWAVES;
        constexpr int I_IN = 16 * 96, I_OUT = 16 * 32, I_G = NE * 16 * 8, I_D = NE * 4 * 32;
        constexpr int NIT = I_IN + I_OUT + 2 * I_G + I_D;
#define MK_ITEM(it_, T_) do { int r = (it_); \
            if (r < I_IN) { const int kb = r / 96, nb = r % 96; T_ = TItem{w_in + 32 * nb, attn_norm, WinT, DIN, 64 * kb, D, 32 * nb, 0}; } \
            else if ((r -= I_IN) < I_OUT) { const int kb = r / 32, nb = r % 32; T_ = TItem{w_out + 32 * nb, (kb < 8) ? on_dil : on_fox - DH, WoutT, D, 64 * kb, D, 32 * nb, 0}; } \
            else if ((r -= I_OUT) < 2 * I_G) { const int up = r >= I_G; if (up) r -= I_G; const int e = r / 128, q = r % 128, kb = q / 8, nb = q % 8, n0 = 32 * nb; \
                T_ = TItem{(up ? w_up : w_gate) + (size_t)e * D * DE + n0, ffn_norm, WguT + (size_t)e * 512 * D, DE, 64 * kb, D, (n0 >> 7) * 256 + up * 128 + (n0 & 127), 0}; } \
            else { r -= 2 * I_G; const int e = r / 128, q = r % 128, kb = q / 32, nb = q % 32; \
                T_ = TItem{w_down + (size_t)e * DE * D + 32 * nb, nullptr, WdT + (size_t)e * D * DE, D, 64 * kb, DE, 32 * nb, 1}; } } while (0)
        for (int it = gw; it < NIT; it += 2 * NGW) {
            TItem ta, tb2; float va[32], vb[32];
            MK_ITEM(it, ta); p0_titem_load(ta, va, lane);
            const bool two = (it + NGW < NIT);
            if (two) { MK_ITEM(it + NGW, tb2); p0_titem_load(tb2, vb, lane); }
            p0_titem_store(ta, va, scr, lane);
            if (two) p0_titem_store(tb2, vb, scr, lane);
        }
#undef MK_ITEM
        for (int it = gw * 64 + lane; it < 48 * 128; it += NGW * 64) { const int n = it >> 7, k8 = (it & 127) * 8; float v[8];
#pragma unroll
            for (int q = 0; q < 8; ++q) { const int k = k8 + q; float w = 0.f; if (n < 32) w = w_re[(size_t)k * NE + n]; else if (n < 36) w = w_rg[(size_t)k * NG + (n - 32)]; v[q] = w * ffn_norm[k]; }
            u32x4 o; o.x = cvt_pk_bf16(v[0], v[1]); o.y = cvt_pk_bf16(v[2], v[3]); o.z = cvt_pk_bf16(v[4], v[5]); o.w = cvt_pk_bf16(v[6], v[7]);
            *(u32x4*)(WrT + (size_t)n * D + k8) = o; }
        }
        __syncthreads();
        LAS unsigned short* wfh = (LAS unsigned short*)(lds); LAS unsigned short* wfl = (LAS unsigned short*)(lds + 32768);
        for (int i = tid; i < 4096; i += NWAVES * 64) ((LAS u32x4*)lds)[i] = (u32x4){0u, 0u, 0u, 0u};
        __syncthreads();
        for (int k = tid; k < D; k += NWAVES * 64) { const float gk = attn_norm[k]; const f32x4 a = *(const f32x4*)(w_in + (size_t)k * DIN + NQKV) * gk, b2 = *(const f32x4*)(w_in + (size_t)k * DIN + NQKV + 4) * gk;
            const int ent = ((k >> 5) * 4 + ((k >> 3) & 3)) * 16, j = k & 7;
#pragma unroll
            for (int c = 0; c < 8; ++c) { const float v = c < 4 ? a[c] : b2[c - 4]; const unsigned hw = cvt_pk_bf16(v, 0.f) & 0xffffu; const float hf = __builtin_bit_cast(float, hw << 16);
                const unsigned lw = cvt_pk_bf16(v - hf, 0.f) & 0xffffu; wfh[(ent + c) * 8 + j] = (unsigned short)hw; wfl[(ent + c) * 8 + j] = (unsigned short)lw; } }
        __syncthreads();
        {
        LAS float* lf = (LAS float*)(lds + 65536);
        LAS float* segs = lf + 1024;
        LAS float* rsl = segs + 128 + wave * 16;
        for (int ch = bx; ch < M / 128; ch += G) {
            const int rl = lane & 15, g_ = lane >> 4; const size_t row = (size_t)ch * 128 + wave * 16 + rl;
            const float* xr = x + row * D + 8 * g_; bf16_t* xo = xb + row * D + 8 * g_;
            f32x4 acc = (f32x4){0.f, 0.f, 0.f, 0.f}; float ss = 0.f;
#pragma unroll 8
            for (int kk = 0; kk < 32; ++kk) {
                const f32x4 v0 = *(const f32x4*)(xr + 32 * kk), v1 = *(const f32x4*)(xr + 32 * kk + 4);
                ss += (v0.x * v0.x + v0.y * v0.y) + (v0.z * v0.z + v0.w * v0.w) + (v1.x * v1.x + v1.y * v1.y) + (v1.z * v1.z + v1.w * v1.w);
                u32x4 hw; hw.x = cvt_pk_bf16(v0.x, v0.y); hw.y = cvt_pk_bf16(v0.z, v0.w); hw.z = cvt_pk_bf16(v1.x, v1.y); hw.w = cvt_pk_bf16(v1.z, v1.w);
                *(u32x4*)(xo + 32 * kk) = hw;
                u32x4 lw; lw.x = cvt_pk_bf16(v0.x - bf_lo(hw.x), v0.y - bf_hi(hw.x)); lw.y = cvt_pk_bf16(v0.z - bf_lo(hw.y), v0.w - bf_hi(hw.y));
                lw.z = cvt_pk_bf16(v1.x - bf_lo(hw.z), v1.y - bf_hi(hw.z)); lw.w = cvt_pk_bf16(v1.z - bf_lo(hw.w), v1.w - bf_hi(hw.w));
                const bf16x8 ah = __builtin_bit_cast(bf16x8, hw), al = __builtin_bit_cast(bf16x8, lw);
                const bf16x8 bh = *(const LAS bf16x8*)(lds + (((kk * 4 + g_) * 16 + rl) * 16)), bl = *(const LAS bf16x8*)(lds + 32768 + (((kk * 4 + g_) * 16 + rl) * 16));
                acc = __builtin_amdgcn_mfma_f32_16x16x32_bf16(ah, bh, acc, 0, 0, 0);
                acc = __builtin_amdgcn_mfma_f32_16x16x32_bf16(al, bh, acc, 0, 0, 0);
                acc = __builtin_amdgcn_mfma_f32_16x16x32_bf16(ah, bl, acc, 0, 0, 0);
            }
            ss += __shfl_xor(ss, 16); ss += __shfl_xor(ss, 32);
            const float rs = 1.0f / sqrtf(ss * (1.0f / D) + EPS);
            if (lane < 16) { rsl[lane] = rs; rstd1[row] = rs; }
            asm volatile("s_waitcnt lgkmcnt(0)" ::: "memory");
            if (rl < 8) { const float bfv = b_forget[rl];
#pragma unroll
                for (int i = 0; i < 4; ++i) { const float z = acc[i] * rsl[4 * g_ + i] + bfv; lf[(wave * 16 + 4 * g_ + i) * 8 + rl] = fminf(z, 0.f) - log1pf(expf(-fabsf(z))); } }
            __syncthreads();
            if (tid < 128) { const int hh = tid & 7, sg = tid >> 3; float s = 0.f;
#pragma unroll
                for (int i = 0; i < 8; ++i) { s += lf[(sg * 8 + i) * 8 + hh]; lf[(sg * 8 + i) * 8 + hh] = s; }
                segs[sg * 8 + hh] = s; }
            __syncthreads();
            if (tid < 8) { float s = 0.f;
#pragma unroll
                for (int i = 0; i < 16; ++i) { const float t_ = segs[i * 8 + tid]; segs[i * 8 + tid] = s; s += t_; }
                ctot[(size_t)ch * 8 + tid] = s; }
            __syncthreads();
            for (int i = tid; i < 1024; i += NWAVES * 64) { const int r_ = i >> 3, hh = i & 7; cl[((size_t)ch * 128 + r_) * 8 + hh] = lf[i] + segs[(r_ >> 3) * 8 + hh]; }
            __syncthreads();
        }
        }
    }
    SEAM(0);

    if (IN(1)) {
        { LAS float* part = (LAS float*)(lds);
          for (int ch = bx; ch < M / 128; ch += G) { const int b_ = ch >> 6, jc = ch & 63, j_ = tid >> 3, hh = tid & 7;
            float v = (j_ < jc) ? ctot[((size_t)b_ * 64 + j_) * NH + hh] : 0.f;
            v += __shfl_xor(v, 8); v += __shfl_xor(v, 16); v += __shfl_xor(v, 32);
            if (lane < 8) part[wave * 8 + lane] = v;
            __syncthreads();
            for (int i = tid; i < 1024; i += NWAVES * 64) { const int h2 = i >> 7, r_ = i & 127; float pre = 0.f;
#pragma unroll
                for (int w_ = 0; w_ < 8; ++w_) pre += part[w_ * 8 + h2];
                cf2[((size_t)b_ * NH + h2) * T + jc * 128 + r_] = (cl[((size_t)ch * 128 + r_) * NH + h2] + pre) * LOG2E; }
            __syncthreads(); } }
        pg8::Gemm g{xb, WinT, M, NQKV, D}; pg8::StaticOrder S; S.init(M, NQKV, G, bx);
        epi::EpiQKV E{qkv, rstd1, nrm};
        pg8::gemm_phase<epi::EpiQKV, pg8::StaticOrder, false>(lds, g, S, E);
    }
    SEAM(1);

    if (IN(2)) {
#ifndef ATT_NP
#define ATT_NP 1
#endif
#pragma unroll 1
        for (int ps = 0; ps < ATT_NP; ++ps) att::attn_phase<0, 0, ATT_NP>(ps, vcu, qkv, og, lse, of, cf2, nrm, rel_bias, (LAS char*)lds);
#pragma unroll 1
        for (int ps = 0; ps < ATT_NP; ++ps) att::attn_phase<0, 1, ATT_NP>(ps, vcu, qkv, og, lse, of, cf2, nrm, rel_bias, (LAS char*)lds);
    }
    SEAM(2);

    if (IN(3)) {
        const int gw = vcu * NWAVES + wave, NGW = G * NWAVES;
        for (int row0 = gw; row0 < M; row0 += 2 * NGW) {
            float od[2][8], ofx[2][8]; float sd[2] = {0.f, 0.f}, sf[2] = {0.f, 0.f};
#pragma unroll
            for (int rr = 0; rr < 2; ++rr) { const int row = row0 + rr * NGW;
                const int hd = lane >> 3;
                float l0 = lse[((size_t)0 * M + row) * NH + hd], l1 = lse[((size_t)1 * M + row) * NH + hd], l2 = lse[((size_t)2 * M + row) * NH + hd];
                const u32x4 a = *(const u32x4*)(og + ((size_t)0 * M + row) * DH + 8 * lane), b2 = *(const u32x4*)(og + ((size_t)1 * M + row) * DH + 8 * lane), c2 = *(const u32x4*)(og + ((size_t)2 * M + row) * DH + 8 * lane);
                const u32x4 f = *(const u32x4*)(of + (size_t)row * DH + 8 * lane);
                const float mx = fmaxf(l0, fmaxf(l1, l2));
                float e0 = __builtin_amdgcn_exp2f(l0 - mx), e1 = __builtin_amdgcn_exp2f(l1 - mx), e2 = __builtin_amdgcn_exp2f(l2 - mx);
                const float inv = 1.0f / (e0 + e1 + e2); e0 *= inv; e1 *= inv; e2 *= inv;
#pragma unroll
                for (int q = 0; q < 4; ++q) {
                    od[rr][2 * q] = e0 * bf_lo(a[q]) + e1 * bf_lo(b2[q]) + e2 * bf_lo(c2[q]); od[rr][2 * q + 1] = e0 * bf_hi(a[q]) + e1 * bf_hi(b2[q]) + e2 * bf_hi(c2[q]);
                    ofx[rr][2 * q] = bf_lo(f[q]); ofx[rr][2 * q + 1] = bf_hi(f[q]);
                    sd[rr] += od[rr][2 * q] * od[rr][2 * q] + od[rr][2 * q + 1] * od[rr][2 * q + 1]; sf[rr] += ofx[rr][2 * q] * ofx[rr][2 * q] + ofx[rr][2 * q + 1] * ofx[rr][2 * q + 1]; } }
#pragma unroll
            for (int o = 1; o < 64; o <<= 1) { sd[0] += __shfl_xor(sd[0], o); sd[1] += __shfl_xor(sd[1], o); sf[0] += __shfl_xor(sf[0], o); sf[1] += __shfl_xor(sf[1], o); }
#pragma unroll
            for (int rr = 0; rr < 2; ++rr) { const int row = row0 + rr * NGW;
                const float rd = 1.0f / sqrtf(sd[rr] * (1.0f / DH) + EPS), rf = 1.0f / sqrtf(sf[rr] * (1.0f / DH) + EPS);
                u32x4 o1, o2;
#pragma unroll
                for (int q = 0; q < 4; ++q) { o1[q] = cvt_pk_bf16(od[rr][2 * q] * rd, od[rr][2 * q + 1] * rd); o2[q] = cvt_pk_bf16(ofx[rr][2 * q] * rf, ofx[rr][2 * q + 1] * rf); }
                *(u32x4*)(On + (size_t)row * D + 8 * lane) = o1; *(u32x4*)(On + (size_t)row * D + DH + 8 * lane) = o2; }
        }
    }
    SEAM(3);

    if (IN(4)) {
        pg8::Gemm g{On, WoutT, M, D, D}; pg8::StaticOrder S; S.init(M, D, G, bx);
        epi::EpiRes E{x, x1b};
        pg8::gemm_phase<epi::EpiRes, pg8::StaticOrder, false>(lds, g, S, E);
    }
    SEAM(4);

    if (IN(5) && !MK_SKIP_MOE) {
        for (int it = tid; it < 48 * 128; it += NWAVES * 64) { const int n = it >> 7, c8 = it & 127, kk = c8 >> 2, g_ = c8 & 3, cb = n >> 4, col = n & 15;
            *(LAS u32x4*)(lds + ((((kk * 3 + cb) * 4 + g_) * 16 + col) * 16)) = *(const u32x4*)(WrT + (size_t)n * D + c8 * 8); }
        LAS float* lg = (LAS float*)(lds + 98304 + wave * 3072);
        LAS int* hist = (LAS int*)(lds + 98304 + 8 * 3072);
        LAS int* gbase = hist + 32;
        __syncthreads();
        for (int ch = bx; ch < M / 128; ch += G) {
            if (tid < 32) hist[tid] = 0;
            const int rl = lane & 15, g_ = lane >> 4; const size_t row = (size_t)ch * 128 + wave * 16 + rl;
            const bf16_t* ar = x1b + row * D + 8 * g_;
            f32x4 acc[3]; acc[0] = (f32x4){0.f, 0.f, 0.f, 0.f}; acc[1] = acc[0]; acc[2] = acc[0];
            float ss = 0.f;
#pragma unroll 16
            for (int kk = 0; kk < 32; ++kk) {
                const bf16x8 a = *(const bf16x8*)(ar + 32 * kk);
                const u32x4 au = __builtin_bit_cast(u32x4, a);
#pragma unroll
                for (int q = 0; q < 4; ++q) { const float lo_ = bf_lo(au[q]), hi_ = bf_hi(au[q]); ss += lo_ * lo_ + hi_ * hi_; }
#pragma unroll
                for (int cb = 0; cb < 3; ++cb) { const bf16x8 bfr = *(const LAS bf16x8*)(lds + ((((kk * 3 + cb) * 4 + g_) * 16 + rl) * 16));
                    acc[cb] = __builtin_amdgcn_mfma_f32_16x16x32_bf16(a, bfr, acc[cb], 0, 0, 0); }
            }
            ss += __shfl_xor(ss, 16); ss += __shfl_xor(ss, 32);
            const float rs2 = 1.0f / sqrtf(ss * (1.0f / D) + EPS);
#pragma unroll
            for (int cb = 0; cb < 3; ++cb)
#pragma unroll
                for (int i = 0; i < 4; ++i) lg[(4 * g_ + i) * 48 + 16 * cb + rl] = acc[cb][i];
            __syncthreads();
            int e_a = 0, e_b = 0, pos_a = 0, pos_b = 0; float w_a = 0.f, w_b = 0.f;
            if (lane < 16) {
                const LAS float* lr = lg + lane * 48;
                float gl[4]; int gi = 0;
#pragma unroll
                for (int i = 0; i < 4; ++i) gl[i] = lr[32 + i] * rs2 + b_rg[i];
                float gm = gl[0];
#pragma unroll
                for (int i = 1; i < 4; ++i) if (gl[i] > gm) { gm = gl[i]; gi = i; }
                float gs = 0.f;
#pragma unroll
                for (int i = 0; i < 4; ++i) gs += expf(gl[i] - gm);
                const float g1 = 1.0f / gs;
                float v1 = -3.0e38f, v2 = -3.0e38f; int i1 = 0, i2 = 0;
#pragma unroll
                for (int i = 0; i < 8; ++i) { const float v = lr[gi * 8 + i] * rs2 + b_re[gi * 8 + i];
                    if (v > v1) { v2 = v1; i2 = i1; v1 = v; i1 = i; } else if (v > v2) { v2 = v; i2 = i; } }
                const float ed = expf(v2 - v1), ga = 1.0f / (1.0f + ed), gb = ed * ga;
                e_a = gi * 8 + i1; e_b = gi * 8 + i2; w_a = g1 * ga; w_b = g1 * gb;
                pos_a = __hip_atomic_fetch_add(hist + e_a, 1, __ATOMIC_RELAXED, __HIP_MEMORY_SCOPE_WORKGROUP); pos_b = __hip_atomic_fetch_add(hist + e_b, 1, __ATOMIC_RELAXED, __HIP_MEMORY_SCOPE_WORKGROUP);
            }
            __syncthreads();
            if (tid < 32) { const int c = hist[tid]; gbase[tid] = c ? (int)__hip_atomic_fetch_add(ctl + CW_ECNT + 64 * tid, (unsigned)c, RLX_AGENT) : 0; }
            __syncthreads();
            if (lane < 16) { const int tok = (int)row;
                const size_t ia = (size_t)e_a * CAP + gbase[e_a] + pos_a, ib = (size_t)e_b * CAP + gbase[e_b] + pos_b;
                list_tok[ia] = tok * 2; list_w[ia] = w_a; list_rs[ia] = rs2;
                list_tok[ib] = tok * 2 + 1; list_w[ib] = w_b; list_rs[ib] = rs2; }
            __syncthreads();
        }
    }
    SEAM(5);

#define MOE_PREFIX() do { LAS int* pre_ = (LAS int*)(lds + MISC_OFF + 64); LAS int* cnt_ = (LAS int*)(lds + MISC_OFF + 256); \
        if (tid == 0) { int s_ = 0; for (int e_ = 0; e_ < NE; ++e_) { const int c_ = (int)__hip_atomic_load(ctl + CW_ECNT + 64 * e_, RLX_AGENT); cnt_[e_] = c_; pre_[e_] = s_; s_ += (c_ + 255) >> 8; } pre_[NE] = s_; } \
        __syncthreads(); } while (0)

    if (IN(6) && !MK_SKIP_MOE) {
        MOE_PREFIX();
        const LAS int* pre = (const LAS int*)(lds + MISC_OFF + 64); const LAS int* cnt = (const LAS int*)(lds + MISC_OFF + 256);
        pg8::Gemm g{x1b, WguT, M, 512, D}; pg8::MoeOrder<1> S{pre, cnt, list_tok, G, vcu};
        epi::EpiGU E{Hb, list_rs, cnt};
        pg8::gemm_phase<epi::EpiGU, pg8::MoeOrder<1>, true>(lds, g, S, E);
    }
    SEAM(6);

    if (IN(7) && !MK_SKIP_MOE) {
        MOE_PREFIX();
        const LAS int* pre = (const LAS int*)(lds + MISC_OFF + 64); const LAS int* cnt = (const LAS int*)(lds + MISC_OFF + 256);
        pg8::Gemm g{Hb, WdT, M, D, DE}; pg8::MoeOrder<2> S{pre, cnt, list_tok, G, vcu};
        epi::EpiDown E{yslot, list_tok, list_w, cnt};
        pg8::gemm_phase<epi::EpiDown, pg8::MoeOrder<2>, false>(lds, g, S, E);
    }
    SEAM(7);

    if (IN(8)) {
        const int gw = vcu * NWAVES + wave, NGW = G * NWAVES;
        for (int row0 = gw; row0 < M; row0 += 2 * NGW) {
            float v[2][16]; float ss[2] = {0.f, 0.f};
#pragma unroll
            for (int rr = 0; rr < 2; ++rr) { const int row = row0 + rr * NGW;
#pragma unroll
              for (int hf = 0; hf < 2; ++hf) {
                const size_t co = (size_t)hf * DH + 8 * lane;
                const u32x4 a = *(const u32x4*)(x1b + (size_t)row * D + co);
#if MK_SKIP_MOE
                const u32x2 y0 = (u32x2){0u, 0u}, y1 = y0;
#else
                const u32x2 y0 = *(const u32x2*)(yslot + ((size_t)row * 2) * D + co), y1 = *(const u32x2*)(yslot + ((size_t)row * 2 + 1) * D + co);
#endif
#pragma unroll
                for (int q = 0; q < 4; ++q) { const f32x2 e0 = (q & 1) ? __builtin_amdgcn_cvt_pk_f32_fp8((int)y0[q >> 1], true) : __builtin_amdgcn_cvt_pk_f32_fp8((int)y0[q >> 1], false);
                    const f32x2 e1 = (q & 1) ? __builtin_amdgcn_cvt_pk_f32_fp8((int)y1[q >> 1], true) : __builtin_amdgcn_cvt_pk_f32_fp8((int)y1[q >> 1], false);
                    const float lo_ = bf_lo(a[q]) + (e0.x + e1.x) * 0.0625f, hi_ = bf_hi(a[q]) + (e0.y + e1.y) * 0.0625f;
                    v[rr][hf * 8 + 2 * q] = lo_; v[rr][hf * 8 + 2 * q + 1] = hi_; ss[rr] += lo_ * lo_ + hi_ * hi_; }
              } }
#pragma unroll
            for (int o = 1; o < 64; o <<= 1) { ss[0] += __shfl_xor(ss[0], o); ss[1] += __shfl_xor(ss[1], o); }
#pragma unroll
            for (int rr = 0; rr < 2; ++rr) { const int row = row0 + rr * NGW;
              const float rs = 1.0f / sqrtf(ss[rr] * (1.0f / D) + EPS);
#pragma unroll
              for (int hf = 0; hf < 2; ++hf) { const size_t co = (size_t)hf * DH + 8 * lane;
                const f32x4 g0 = *(const f32x4*)(final_norm + co), g1 = *(const f32x4*)(final_norm + co + 4);
                f32x4 o0, o1;
#pragma unroll
                for (int q = 0; q < 4; ++q) { o0[q] = v[rr][hf * 8 + q] * rs * g0[q]; o1[q] = v[rr][hf * 8 + 4 + q] * rs * g1[q]; }
                *(f32x4*)(args.out + (size_t)row * D + co) = o0; *(f32x4*)(args.out + (size_t)row * D + co + 4) = o1; } }
        }
    }
#undef IN
#undef SEAM
}

#ifndef MK_N_LAUNCHES
#define MK_N_LAUNCHES 1
#endif
extern "C" void kernel_launch(void* const* d_in, const int* in_sizes, int n_in, void* d_out, int out_size, void* d_ws, size_t ws_size, hipStream_t stream) {
    static int grid = 0;
    if (grid == 0) {
        if (n_in != 17 || in_sizes[0] != M * D || out_size != M * D || ws_size < WS_END) { fprintf(stderr, "kernel_launch: unexpected shapes (n_in %d in0 %d out %d ws %zu)\n", n_in, n_in > 0 ? in_sizes[0] : -1, out_size, ws_size); grid = -1; return; }
        int dev = 0, cus = 0, per_cu = 0;
        if (hipGetDevice(&dev) != hipSuccess || hipDeviceGetAttribute(&cus, hipDeviceAttributeMultiprocessorCount, dev) != hipSuccess) { grid = -1; return; }
        if (hipFuncSetAttribute((const void*)hymba_fwd, hipFuncAttributeMaxDynamicSharedMemorySize, LDS_BYTES) != hipSuccess) { fprintf(stderr, "kernel_launch: hipFuncSetAttribute failed\n"); grid = -1; return; }
        if (hipOccupancyMaxActiveBlocksPerMultiprocessor(&per_cu, (const void*)hymba_fwd, NWAVES * 64, LDS_BYTES) != hipSuccess || per_cu < 1) { fprintf(stderr, "kernel_launch: occupancy query says %d\n", per_cu); }
        (void)hipGetLastError();
        grid = cus;
        if (grid > 256) grid = 256;
    }
    if (grid < 0) return;
    (void)hipMemsetAsync((char*)d_ws + WS_CTL, 0, CTL_ZERO_BYTES, stream);
    Args a{};
    for (int i = 0; i < 17; ++i) a.in[i] = (const float*)d_in[i];
    a.out = (float*)d_out; a.ws = (unsigned char*)d_ws;
#if MK_N_LAUNCHES == 1
    a.ph_lo = 0; a.ph_hi = N_PHASES;
    hipLaunchKernelGGL(hymba_fwd, dim3(grid), dim3(NWAVES * 64), LDS_BYTES, stream, a);
#else
    for (int p = 0; p < N_PHASES; ++p) { a.ph_lo = p; a.ph_hi = p + 1; hipLaunchKernelGGL(hymba_fwd, dim3(grid), dim3(NWAVES * 64), LDS_BYTES, stream, a); }
#endif
}
```

```cpp
#include <hip/hip_runtime.h>
#include <hip/hip_bf16.h>
#include <cstdio>
#include <cstdint>

#define GAS __attribute__((address_space(1)))
#define LAS __attribute__((address_space(3)))
typedef unsigned short bf16_t;
typedef short bf16x8 __attribute__((ext_vector_type(8)));
typedef short s16x4 __attribute__((ext_vector_type(4)));
typedef float f32x4 __attribute__((ext_vector_type(4)));
typedef float f32x2 __attribute__((ext_vector_type(2)));
typedef float f32x16 __attribute__((ext_vector_type(16)));
typedef unsigned u32x4 __attribute__((ext_vector_type(4)));
typedef unsigned u32x2 __attribute__((ext_vector_type(2)));
typedef __bf16 bf16x2_t __attribute__((ext_vector_type(2)));

constexpr int BATCH = 4, T = 8192, D = 1024, M = BATCH * T;
constexpr int NH = 8, HD = 64, DH = NH * HD;
constexpr int NQKV = 6 * DH;
constexpr int DIN = NQKV + NH;
constexpr int NE = 32, DE = 256, EPG = 8, NG = 4;
constexpr int CAP = M;
constexpr float EPS = 1e-6f;
constexpr float LOG2E = 1.4426950408889634f;
constexpr float C2 = 0.125f * LOG2E;
constexpr float NEGBIG = -1e30f;

__device__ __forceinline__ unsigned cvt_pk_bf16(float lo, float hi) { f32x2 v = {lo, hi}; bf16x2_t b = __builtin_convertvector(v, bf16x2_t); return __builtin_bit_cast(unsigned, b); }
__device__ __forceinline__ float bf_lo(unsigned w) { return __builtin_bit_cast(float, w << 16); }
__device__ __forceinline__ float bf_hi(unsigned w) { return __builtin_bit_cast(float, w & 0xffff0000u); }

namespace pg8 {
#define PG8_LAS __attribute__((address_space(3)))
constexpr int BM = 256, BK = 64, HALF = 128, HTB = HALF * BK * 2  , STAGE_BYTES = 8 * HTB, NXCD = 8, WGM = 8;

__host__ __device__ __forceinline__ int lds_byte(int r, int c) { const int st = (r >> 4) * 2 + (c >> 5), rr = r & 15, cc = c & 31, ob = rr * 64 + cc * 2; return st * 1024 + (ob ^ (((ob >> 9) & 1) << 5)); }
__host__ __device__ __forceinline__ void stage_rc(int b, int& R, int& C) { const int st = b / 1024, sb = b % 1024, swz = sb ^ (((sb >> 9) & 1) << 5); R = (st >> 1) * 16 + swz / 64; C = (st & 1) * 32 + (swz % 64) / 2; }
__host__ __device__ __forceinline__ int perm32(int rho) { const int n = rho >> 4, i = rho & 15; return 8 * (i >> 2) + 4 * n + (i & 3); }

struct Unit { int pm, pn, e, ti; };
struct Gemm { const bf16_t* A; const bf16_t* Bt; int M, N, K; };

struct StaticOrder {
    int nM, nN, nwg, G, c;
    __host__ __device__ void init(int M_, int N_, int G_, int c_) { nM = M_ / BM; nN = N_ / BM; nwg = nM * nN; G = G_; c = c_; }
    __host__ __device__ bool next(int i, Unit& u) const {
        const long L = (long)i * G + c; if (L >= nwg) return false;
        int wgid = (int)L; { const int q = nwg / NXCD, r = nwg % NXCD, xcd = wgid % NXCD, off = wgid / NXCD; wgid = (xcd < r ? xcd * (q + 1) : r * (q + 1) + (xcd - r) * q) + off; }
        const int nig = WGM * nN, gid = wgid / nig, fm = gid * WGM, gsz = (nM - fm) < WGM ? (nM - fm) : WGM;
        u.pm = fm + ((wgid % nig) % gsz); u.pn = (wgid % nig) / gsz; u.e = 0; u.ti = 0; return true;
    }
    __device__ __forceinline__ int row_token(const Unit&, int) const { return 0; }
};

template <int SH> struct MoeOrder {
    static constexpr int npn = 1 << SH;
    const PG8_LAS int* pre; const PG8_LAS int* cnt; const int* list_tok; int G, c;
    __device__ __forceinline__ bool next(int i, Unit& u) const {
        const int L = i * G + c, total = __builtin_amdgcn_readfirstlane(pre[32]);
        if (L >= total * npn) return false;
        const int tf = L >> SH, pn = L & (npn - 1);
        int e = 0;
#pragma unroll 1
        for (int k = 16; k >= 1; k >>= 1) { const int pv = __builtin_amdgcn_readfirstlane(pre[e + k]); if (pv <= tf) e += k; }
        const int pe = __builtin_amdgcn_readfirstlane(pre[e]);
        u.e = e; u.ti = tf - pe; u.pm = tf; u.pn = e * npn + pn; return true;
    }
    __device__ __forceinline__ int row_token(const Unit& u, int r) const { int idx = u.ti * 256 + r; idx = idx < cnt[u.e] ? idx : 0; return list_tok[(size_t)u.e * CAP + idx] >> 1; }
};

template <class Epi, class Sched, bool GATHER, bool ALIGN_EPI = true>
__device__ __forceinline__ void gemm_phase(PG8_LAS unsigned char* lds, const Gemm g, const Sched& S, const Epi& E) {
    const int tid = threadIdx.x, wid = __builtin_amdgcn_readfirstlane(tid >> 6), lane = tid & 63, wr = wid >> 2, wc = wid & 3, fr = lane & 15, fq = lane >> 4;
    const int K = g.K, nt = K / BK;
    unsigned voffA[2], voffB[2]; int RA[2], CA[2];
#pragma unroll
    for (int i = 0; i < 2; ++i) { int R, C; stage_rc(tid * 16 + i * 8192, R, C); const int Rb = Epi::PERM ? ((R & ~31) + perm32(R & 31)) : R;
        voffA[i] = (unsigned)(R * K + C) * 2u; voffB[i] = (unsigned)(Rb * K + C) * 2u; RA[i] = R; CA[i] = C; }
    const size_t kstep = (size_t)(BK * 2);
    const size_t hstep = (size_t)HALF * K * 2;
    const size_t tstep = 2 * hstep;
    const unsigned ldsw = (unsigned)wid * 1024u;
    const int aoff = lds_byte(wr * 64 + fr, fq * 8), boff = lds_byte(wc * 32 + fr, fq * 8);
#define PG8_SA(b, h) (((b) * 2 + (h)) * HTB)
#define PG8_SB(b, h) ((4 + (b) * 2 + (h)) * HTB)
#define PG8_STAGE(bufoff, gbase, voff) do { _Pragma("unroll") for (int _i = 0; _i < 2; ++_i) \
        __builtin_amdgcn_global_load_lds((const unsigned*)((const char*)(gbase) + (voff)[_i]), (PG8_LAS unsigned*)(lds + (bufoff) + ldsw + _i * 8192), 16, 0, 0); } while (0)
#define PG8_STAGE_A(bufoff, ap, h, offs) do { if constexpr (GATHER) { PG8_STAGE(bufoff, ap, offs[h]); } else { PG8_STAGE(bufoff, (ap) + (h) * hstep, voffA); } } while (0)
#define PG8_LDA(dst, b, h) do { _Pragma("unroll") for (int m = 0; m < 4; ++m) _Pragma("unroll") for (int k = 0; k < 2; ++k) dst[m][k] = *(const PG8_LAS bf16x8*)(lds + PG8_SA(b, h) + aoff + m * 2048 + k * 1024); } while (0)
#define PG8_LDB(dst, b, h) do { _Pragma("unroll") for (int n = 0; n < 2; ++n) _Pragma("unroll") for (int k = 0; k < 2; ++k) dst[n][k] = *(const PG8_LAS bf16x8*)(lds + PG8_SB(b, h) + boff + n * 2048 + k * 1024); } while (0)
#define PG8_MMA(ai, bj, At, Bt) do { __builtin_amdgcn_s_setprio(1); _Pragma("unroll") for (int m = 0; m < 4; ++m) _Pragma("unroll") for (int n = 0; n < 2; ++n) _Pragma("unroll") for (int k = 0; k < 2; ++k) \
        acc[ai][bj][m][n] = __builtin_amdgcn_mfma_f32_16x16x32_bf16(Bt[n][k], At[m][k], acc[ai][bj][m][n], 0, 0, 0); __builtin_amdgcn_s_setprio(0); } while (0)
#define PG8_WAIT_V(n) asm volatile("s_waitcnt vmcnt(" #n ")" ::: "memory")
#define PG8_WAIT_L(n) asm volatile("s_waitcnt lgkmcnt(" #n ")" ::: "memory")
#define PG8_BAR __builtin_amdgcn_s_barrier()
#define PG8_SCHED __builtin_amdgcn_sched_barrier(0)
#define PG8_GOFFS(u_, v_) do { if constexpr (GATHER) { _Pragma("unroll") for (int h_ = 0; h_ < 2; ++h_) _Pragma("unroll") for (int i_ = 0; i_ < 2; ++i_) \
        v_[h_][i_] = (unsigned)(S.row_token(u_, h_ * HALF + RA[i_]) * K + CA[i_]) * 2u; } } while (0)
    Unit cur, nxt; int ui = 0;
    if (!S.next(0, cur)) return;
    f32x4 acc[2][2][4][2];
#pragma unroll
    for (int a = 0; a < 2; ++a)
#pragma unroll
        for (int b = 0; b < 2; ++b)
#pragma unroll
            for (int m = 0; m < 4; ++m)
#pragma unroll
                for (int n = 0; n < 2; ++n) acc[a][b][m][n] = (f32x4){0.f, 0.f, 0.f, 0.f};
    bf16x8 At[4][2], B0[2][2], B1[2][2];
    unsigned vA[2][2] = {{0u, 0u}, {0u, 0u}}, nvA[2][2] = {{0u, 0u}, {0u, 0u}};
    PG8_GOFFS(cur, vA);
    const char* cA = GATHER ? (const char*)g.A : (const char*)g.A + (size_t)cur.pm * tstep; const char* cB = (const char*)g.Bt + (size_t)cur.pn * tstep;
    PG8_STAGE(PG8_SB(0, 0), cB, voffB); PG8_STAGE(PG8_SB(0, 1), cB + hstep, voffB); PG8_STAGE_A(PG8_SA(0, 0), cA, 0, vA); PG8_STAGE_A(PG8_SA(0, 1), cA, 1, vA);
    if (wr == 1) PG8_BAR;
    PG8_WAIT_V(2); PG8_BAR;
    PG8_STAGE(PG8_SB(1, 0), cB + kstep, voffB); PG8_STAGE_A(PG8_SA(1, 0), cA + kstep, 0, vA); PG8_STAGE(PG8_SB(1, 1), cB + hstep + kstep, voffB);
    PG8_WAIT_V(6); PG8_BAR;
    for (;;) {
        const bool has_next = S.next(ui + 1, nxt);
        if (has_next) { PG8_GOFFS(nxt, nvA); } else { if constexpr (GATHER) {
#pragma unroll
            for (int h_ = 0; h_ < 2; ++h_)
#pragma unroll
                for (int i_ = 0; i_ < 2; ++i_) nvA[h_][i_] = vA[h_][i_]; } }
        const char* nA = GATHER ? cA : (has_next ? (const char*)g.A + (size_t)nxt.pm * tstep : cA); const char* nB = has_next ? (const char*)g.Bt + (size_t)nxt.pn * tstep : cB;
#pragma unroll 1
        for (int t = 0; t < nt; t += 2) {
            const bool last = (t == nt - 2);
            const char* a1 = cA + (size_t)(t + 1) * kstep;
            const char* a2 = last ? nA : cA + (size_t)(t + 2) * kstep; const char* b2 = last ? nB : cB + (size_t)(t + 2) * kstep;
            const char* a3 = a2 + kstep; const char* b3 = b2 + kstep;
            unsigned sA[2][2];
#pragma unroll
            for (int h_ = 0; h_ < 2; ++h_)
#pragma unroll
                for (int i_ = 0; i_ < 2; ++i_) sA[h_][i_] = last ? nvA[h_][i_] : vA[h_][i_];
            PG8_LDB(B0, 0, 0); PG8_LDB(B1, 0, 1); PG8_SCHED; PG8_LDA(At, 0, 0); PG8_STAGE_A(PG8_SA(1, 1), a1, 1, vA);
            PG8_WAIT_V(8); PG8_WAIT_L(0); PG8_BAR; PG8_MMA(0, 0, At, B0); PG8_MMA(0, 1, At, B1); PG8_BAR; PG8_SCHED;
            PG8_LDA(At, 0, 1); PG8_STAGE(PG8_SB(0, 0), b2, voffB); PG8_STAGE(PG8_SB(0, 1), b2 + hstep, voffB); PG8_STAGE_A(PG8_SA(0, 0), a2, 0, sA);
            PG8_WAIT_V(8); PG8_WAIT_L(0); PG8_BAR; PG8_MMA(1, 0, At, B0); PG8_MMA(1, 1, At, B1); PG8_BAR; PG8_SCHED;
            PG8_LDB(B0, 1, 0); PG8_LDB(B1, 1, 1); PG8_SCHED; PG8_LDA(At, 1, 0); PG8_STAGE_A(PG8_SA(0, 1), a2, 1, sA);
            PG8_WAIT_V(8); PG8_WAIT_L(0); PG8_BAR; PG8_MMA(0, 0, At, B0); PG8_MMA(0, 1, At, B1); PG8_BAR; PG8_SCHED;
            PG8_LDA(At, 1, 1); PG8_STAGE(PG8_SB(1, 0), b3, voffB); PG8_STAGE(PG8_SB(1, 1), b3 + hstep, voffB); PG8_STAGE_A(PG8_SA(1, 0), a3, 0, sA);
            PG8_WAIT_V(8); PG8_WAIT_L(0); PG8_BAR; PG8_MMA(1, 0, At, B0); PG8_MMA(1, 1, At, B1); PG8_BAR; PG8_SCHED;
        }
        if constexpr (ALIGN_EPI) { if (wr == 0) PG8_BAR; }
        E(acc, cur, wr, wc, fr, fq);
        if (!has_next) break;
#pragma unroll
        for (int a = 0; a < 2; ++a)
#pragma unroll
            for (int b = 0; b < 2; ++b)
#pragma unroll
                for (int m = 0; m < 4; ++m)
#pragma unroll
                    for (int n = 0; n < 2; ++n) acc[a][b][m][n] = (f32x4){0.f, 0.f, 0.f, 0.f};
        cur = nxt; cA = nA; cB = nB; ++ui;
#pragma unroll
        for (int h_ = 0; h_ < 2; ++h_)
#pragma unroll
            for (int i_ = 0; i_ < 2; ++i_) vA[h_][i_] = nvA[h_][i_];
        if constexpr (ALIGN_EPI) { if (wr == 1) PG8_BAR; }
    }
    PG8_WAIT_V(0);
    if constexpr (!ALIGN_EPI) { if (wr == 0) PG8_BAR; }
    PG8_BAR;
#undef PG8_SA
#undef PG8_SB
#undef PG8_STAGE
#undef PG8_STAGE_A
#undef PG8_LDA
#undef PG8_LDB
#undef PG8_MMA
#undef PG8_WAIT_V
#undef PG8_WAIT_L
#undef PG8_BAR
#undef PG8_SCHED
#undef PG8_GOFFS
}
}
namespace epi {
using pg8::Unit;
__device__ __forceinline__ u32x4 pack8(f32x4 v0, f32x4 v1) { u32x4 w; w.x = cvt_pk_bf16(v0[0], v0[1]); w.y = cvt_pk_bf16(v0[2], v0[3]); w.z = cvt_pk_bf16(v1[0], v1[1]); w.w = cvt_pk_bf16(v1[2], v1[3]); return w; }

struct EpiQKV {
    static constexpr bool PERM = true;
    bf16_t* O; const float* rstd; float* nrm;
    __device__ __forceinline__ void operator()(const f32x4 (&acc)[2][2][4][2], const Unit& u, int wr, int wc, int fr, int fq) const {
        const int t = u.pn >> 1, cin = (u.pn & 1) * 256 + wc * 32 + 8 * fq;
        bf16_t* base = O + (size_t)t * ((size_t)M * DH);
        const float sc = (t == 0 || t == 3) ? C2 : 1.f;
        const bool do_n = (t == 3 || t == 4);
        const int row0 = u.pm * 256 + wr * 64 + fr;
        float mx[2][2] = {{0.f, 0.f}, {0.f, 0.f}};
#pragma unroll
        for (int ai = 0; ai < 2; ++ai)
#pragma unroll
            for (int m = 0; m < 4; ++m) { const int r = row0 + ai * 128 + m * 16; const float rs = rstd[r] * sc; bf16_t* rowp = base + (size_t)r * DH + cin;
#pragma unroll
                for (int bj = 0; bj < 2; ++bj) { const f32x4 v0 = acc[ai][bj][m][0] * rs, v1 = acc[ai][bj][m][1] * rs;
                    *(u32x4*)(rowp + bj * 128) = pack8(v0, v1);
                    if (do_n) { float s = (v0[0] * v0[0] + v0[1] * v0[1]) + (v0[2] * v0[2] + v0[3] * v0[3]) + (v1[0] * v1[0] + v1[1] * v1[1]) + (v1[2] * v1[2] + v1[3] * v1[3]);
                        s += __shfl_xor(s, 16); s += __shfl_xor(s, 32); mx[ai][bj] = fmaxf(mx[ai][bj], s); } } }
        if (do_n) {
#pragma unroll
            for (int ai = 0; ai < 2; ++ai)
#pragma unroll
                for (int bj = 0; bj < 2; ++bj) { float v = mx[ai][bj];
                    v = fmaxf(v, __shfl_xor(v, 1)); v = fmaxf(v, __shfl_xor(v, 2)); v = fmaxf(v, __shfl_xor(v, 4)); v = fmaxf(v, __shfl_xor(v, 8));
                    const int tile64 = u.pm * 4 + ai * 2 + wr, head = (u.pn & 1) * 4 + 2 * bj + (wc >> 1);
                    if ((threadIdx.x & 63) == 0) nrm[(((size_t)(t - 3) * (M / 64) + tile64) * NH + head) * 2 + (wc & 1)] = v; }
        }
    }
};

struct EpiRes {
    static constexpr bool PERM = true;
    const float* x; bf16_t* x1b;
    __device__ __forceinline__ void operator()(const f32x4 (&acc)[2][2][4][2], const Unit& u, int wr, int wc, int fr, int fq) const {
        const int row0 = u.pm * 256 + wr * 64 + fr, col0 = u.pn * 256 + wc * 32 + 8 * fq;
#pragma unroll
        for (int ai = 0; ai < 2; ++ai)
#pragma unroll
            for (int m = 0; m < 4; ++m) { const size_t off = (size_t)(row0 + ai * 128 + m * 16) * D + col0;
#pragma unroll
                for (int bj = 0; bj < 2; ++bj) { const f32x4 x0 = *(const f32x4*)(x + off + bj * 128), x1 = *(const f32x4*)(x + off + bj * 128 + 4);
                    *(u32x4*)(x1b + off + bj * 128) = pack8(acc[ai][bj][m][0] + x0, acc[ai][bj][m][1] + x1); } if (m & 1) asm volatile("" ::: "memory"); }
    }
};

struct EpiGU {
    static constexpr bool PERM = true;
    bf16_t* H; const float* list_rs; const LAS int* cnt;
    __device__ __forceinline__ void operator()(const f32x4 (&acc)[2][2][4][2], const Unit& u, int wr, int wc, int fr, int fq) const {
        const int pn = u.pn & 1, col0 = pn * 128 + wc * 32 + 8 * fq, r0 = wr * 64 + fr, ne = cnt[u.e];
        float rsv[2][4];
#pragma unroll
        for (int ai = 0; ai < 2; ++ai)
#pragma unroll
            for (int m = 0; m < 4; ++m) { int idx = u.ti * 256 + r0 + ai * 128 + m * 16; idx = idx < ne ? idx : 0; rsv[ai][m] = list_rs[(size_t)u.e * CAP + idx]; }
#pragma unroll
        for (int ai = 0; ai < 2; ++ai)
#pragma unroll
            for (int m = 0; m < 4; ++m) { const int r = r0 + ai * 128 + m * 16; const float rs = rsv[ai][m];
                f32x4 hv[2];
#pragma unroll
                for (int n = 0; n < 2; ++n) { const f32x4 gt = acc[ai][0][m][n] * rs, up = acc[ai][1][m][n] * rs;
#pragma unroll
                    for (int q = 0; q < 4; ++q) { const float sg = gt[q] * __builtin_amdgcn_rcpf(1.f + __builtin_amdgcn_exp2f(-gt[q] * LOG2E)); hv[n][q] = sg * up[q]; } }
                *(u32x4*)(H + ((size_t)u.pm * 256 + r) * DE + col0) = pack8(hv[0], hv[1]); }
    }
};

struct EpiDown {
    static constexpr bool PERM = true;
    unsigned char* Y; const int* list_tok; const float* list_w; const LAS int* cnt;
    __device__ __forceinline__ void operator()(const f32x4 (&acc)[2][2][4][2], const Unit& u, int wr, int wc, int fr, int fq) const {
        const int pn = u.pn & 3, col0 = pn * 256 + wc * 64 + 16 * fq, r0 = wr * 64 + fr, ne = cnt[u.e];
        int tsv[2][4]; float wv[2][4];
#pragma unroll
        for (int ai = 0; ai < 2; ++ai)
#pragma unroll
            for (int m = 0; m < 4; ++m) { const int idx = u.ti * 256 + r0 + ai * 128 + m * 16; const int ic = idx < ne ? idx : 0;
                const int t_ = list_tok[(size_t)u.e * CAP + ic]; tsv[ai][m] = (idx < ne) ? t_ : 2 * M; wv[ai][m] = list_w[(size_t)u.e * CAP + ic] * 16.0f; }
#pragma unroll
        for (int ai = 0; ai < 2; ++ai)
#pragma unroll
            for (int m = 0; m < 4; ++m) { const float w = wv[ai][m]; u32x4 o;
#pragma unroll
                for (int bj = 0; bj < 2; ++bj)
#pragma unroll
                    for (int n = 0; n < 2; ++n) { const f32x4 v = acc[ai][bj][m][n] * w; int pk = 0;
                        pk = __builtin_amdgcn_cvt_pk_fp8_f32(v[0], v[1], pk, false); pk = __builtin_amdgcn_cvt_pk_fp8_f32(v[2], v[3], pk, true); o[bj * 2 + n] = (unsigned)pk; }
                *(u32x4*)(Y + (size_t)tsv[ai][m] * D + col0) = o; }
    }
};
}
namespace att {
constexpr int PITCH = DH;
constexpr int NSLOT = 6, SLOTB = 8192, PF = 5;
constexpr int L_K = 0, L_V = NSLOT * SLOTB, L_TAB = 2 * NSLOT * SLOTB;
constexpr int TABN = 336;
constexpr int L_CK = L_TAB + 8192;
constexpr int L_MISC = L_CK + 32768;
constexpr int L_END = L_MISC + 1024;
typedef LAS const char* lds_cptr;
typedef short v4i16_t __attribute__((ext_vector_type(4)));

__device__ const unsigned char BUCKET[3][132] = {
 {0,1,2,3,4,5,6,7,8,9,10,11,12,13,14,15,16,16,16,16,16,16,17,17,17,17,17,17,17,17,18,18,18,18,18,18,18,18,18,18,19,19,19,19,19,19,19,19,19,19,19,19,19,19,20,20,20,20,20,20,20,20,20,20,20,20,20,20,20,20,20,20,20,21,21,21,21,21,21,21,21,21,21,21,21,21,21,21,21,21,21,21,21,21,21,21,21,21,21,22,22,22,22,22,22,22,22,22,22,22,22,22,22,22,22,22,22,22,22,22,22,22,22,22,22,22,22,22,22,0,0,0},
 {0,4,8,12,16,16,17,17,18,18,19,19,19,19,20,20,20,20,20,21,21,21,21,21,21,22,22,22,22,22,22,22,22,22,23,23,23,23,23,23,23,23,23,23,23,23,24,24,24,24,24,24,24,24,24,24,24,24,24,24,24,24,25,25,25,25,25,25,25,25,25,25,25,25,25,25,25,25,25,25,25,25,25,26,26,26,26,26,26,26,26,26,26,26,26,26,26,26,26,26,26,26,26,26,26,26,26,26,26,26,26,26,26,27,27,27,27,27,27,27,27,27,27,27,27,27,27,27,27,0,0,0},
 {0,16,18,19,20,21,21,22,22,23,23,23,24,24,24,24,25,25,25,25,25,26,26,26,26,26,26,26,26,27,27,27,27,27,27,27,27,27,27,28,28,28,28,28,28,28,28,28,28,28,28,28,29,29,29,29,29,29,29,29,29,29,29,29,29,29,29,29,29,29,30,30,30,30,30,30,30,30,30,30,30,30,30,30,30,30,30,30,30,30,30,30,30,30,30,31,31,31,31,31,31,31,31,31,31,31,31,31,31,31,31,31,31,31,31,31,31,31,31,31,31,31,31,31,31,31,31,31,31,0,0,0}};

__device__ __forceinline__ int crow(int r, int hi) { return (r & 3) + 8 * (r >> 2) + 4 * hi; }
__device__ __forceinline__ s16x4 vtr(lds_cptr p) { return __builtin_bit_cast(s16x4, __builtin_amdgcn_ds_read_tr16_b64_v4i16((LAS v4i16_t*)p)); }
__device__ __forceinline__ void glds16(const void* gsrc, unsigned lds_dst) { unsigned keep;
    asm volatile("s_mov_b32 %0, m0\n\ts_mov_b32 m0, %2\n\ts_nop 0\n\tglobal_load_lds_dwordx4 %1, off\n\ts_mov_b32 m0, %0" : "=&s"(keep) : "v"(gsrc), "s"(lds_dst) : "memory"); }
__device__ __forceinline__ void glds4(const void* gsrc, unsigned lds_dst) { unsigned keep;
    asm volatile("s_mov_b32 %0, m0\n\ts_mov_b32 m0, %2\n\ts_nop 0\n\tglobal_load_lds_dword %1, off\n\ts_mov_b32 m0, %0" : "=&s"(keep) : "v"(gsrc), "s"(lds_dst) : "memory"); }
#define ATT_WAIT_BAR(N) asm volatile("s_waitcnt vmcnt(" #N ") lgkmcnt(0)\n\ts_barrier" ::: "memory")

__device__ __forceinline__ float max3f(float a, float b, float c) { float r; asm("v_max3_f32 %0, %1, %2, %3" : "=v"(r) : "v"(a), "v"(b), "v"(c)); return r; }
__device__ __forceinline__ float fadd_s(float a, float b) { float r; asm("v_add_f32_e32 %0, %1, %2" : "=v"(r) : "v"(a), "v"(b)); return r; }
struct WaveState { float mref, l; f32x16 o0, o1, negm; };
__device__ __forceinline__ void ws_reset(WaveState& st) { st.mref = 0.f; st.l = 0.f;
#pragma unroll
    for (int r = 0; r < 16; ++r) { st.o0[r] = 0.f; st.o1[r] = 0.f; st.negm[r] = 0.f; } }

template <bool SUB, int PVT = 0>
__device__ __forceinline__ void tile_compute(lds_cptr kslot, const int (&kofs)[4], lds_cptr vslot, const bf16x8 (&qr)[4], const LAS float* tb, bool band, int qpos, int kpos0,
                                             WaveState& st, int& started, int r32, int hi, int lane) {
    f32x16 p0, p1;
    const lds_cptr vb = vslot + ((lane >> 4) & 1) * 32 + (lane & 3) * 8 + (4 * hi + ((lane & 15) >> 2)) * 64;
    bf16x8 kf[8]; f32x4 tt[8];
#pragma unroll
    for (int d0 = 0; d0 < 4; ++d0) { kf[2 * d0] = *(const LAS bf16x8*)(kslot + kofs[d0]); kf[2 * d0 + 1] = *(const LAS bf16x8*)(kslot + kofs[d0] + 4096); }
#pragma unroll
    for (int g = 0; g < 4; ++g) { tt[2 * g] = *(const LAS f32x4*)(tb + 8 * g + 4 * hi); tt[2 * g + 1] = *(const LAS f32x4*)(tb + 32 + 8 * g + 4 * hi); }
    __builtin_amdgcn_sched_barrier(0);
    p0 = __builtin_amdgcn_mfma_f32_32x32x16_bf16(kf[0], qr[0], st.negm, 0, 0, 0);
    p1 = __builtin_amdgcn_mfma_f32_32x32x16_bf16(kf[1], qr[0], st.negm, 0, 0, 0);
#pragma unroll
    for (int d0 = 1; d0 < 4; ++d0) {
        p0 = __builtin_amdgcn_mfma_f32_32x32x16_bf16(kf[2 * d0], qr[d0], p0, 0, 0, 0);
        p1 = __builtin_amdgcn_mfma_f32_32x32x16_bf16(kf[2 * d0 + 1], qr[d0], p1, 0, 0, 0);
    }
    s16x4 vf[16];
#pragma unroll
    for (int ks = 0; ks < 4; ++ks) { vf[4 * ks] = vtr(vb + ks * 1024); vf[4 * ks + 1] = vtr(vb + ks * 1024 + 512); vf[4 * ks + 2] = vtr(vb + 4096 + ks * 1024); vf[4 * ks + 3] = vtr(vb + 4096 + ks * 1024 + 512); }
    __builtin_amdgcn_sched_barrier(0);
#pragma unroll
    for (int g = 0; g < 4; ++g) {
#pragma unroll
        for (int q = 0; q < 4; ++q) { if (SUB) { p0[4 * g + q] -= tt[2 * g][q]; p1[4 * g + q] -= tt[2 * g + 1][q]; } else { p0[4 * g + q] += tt[2 * g][q]; p1[4 * g + q] += tt[2 * g + 1][q]; } } }
    if (band) {
#pragma unroll
        for (int r = 0; r < 16; ++r) { const int kv = kpos0 + crow(r, hi); if (kv > qpos) p0[r] = NEGBIG; if (kv + 32 > qpos) p1[r] = NEGBIG; }
    }
    float rm, rm2;
    { rm = max3f(p0[0], p0[1], p1[0]); rm2 = max3f(p0[2], p0[3], p1[1]); rm = max3f(rm, p1[2], p1[3]);
#pragma unroll
      for (int r = 4; r < 16; r += 4) { rm = max3f(rm, p0[r], p0[r + 1]); rm2 = max3f(rm2, p0[r + 2], p0[r + 3]); rm = max3f(rm, p1[r], p1[r + 1]); rm2 = max3f(rm2, p1[r + 2], p1[r + 3]); }
      rm = fmaxf(rm, rm2); }
    { auto rr = __builtin_amdgcn_permlane32_swap(__float_as_uint(rm), __float_as_uint(rm), false, false); rm = fmaxf(__uint_as_float(rr[0]), __uint_as_float(rr[1])); }
    if (PVT == 3) { st.l += rm; return; }
    if (started && __all(rm < -32.0f)) return;
    started = 1;
    if (__any(rm > 8.0f)) {
        const float dl = fmaxf(rm, 0.f), f = __builtin_amdgcn_exp2f(-dl);
        st.mref += dl; st.l *= f;
#pragma unroll
        for (int r = 0; r < 16; ++r) { p0[r] -= dl; p1[r] -= dl; st.o0[r] *= f; st.o1[r] *= f; st.negm[r] = -st.mref; }
    }
#pragma unroll
    for (int r = 0; r < 16; ++r) { p0[r] = __builtin_amdgcn_exp2f(p0[r]); p1[r] = __builtin_amdgcn_exp2f(p1[r]); }
    { float sa = p0[0], sb = p1[0];
#pragma unroll
      for (int r = 1; r < 16; ++r) { sa += p0[r]; asm volatile("" : "+v"(sa)); sb += p1[r]; asm volatile("" : "+v"(sb)); }
      st.l += sa + sb; }
    u32x4 pw[4];
#pragma unroll
    for (int s = 0; s < 2; ++s)
#pragma unroll
        for (int j = 0; j < 4; ++j) { pw[s][j] = cvt_pk_bf16(p0[8 * s + 2 * j], p0[8 * s + 2 * j + 1]); pw[2 + s][j] = cvt_pk_bf16(p1[8 * s + 2 * j], p1[8 * s + 2 * j + 1]); }
    __builtin_amdgcn_sched_barrier(0);
#pragma unroll
    for (int ks = 0; ks < 4; ++ks) {
        const s16x4 a_lo = vf[4 * ks], a_hi = vf[4 * ks + 1], b_lo = vf[4 * ks + 2], b_hi = vf[4 * ks + 3];
        const bf16x8 va = (bf16x8){a_lo[0], a_lo[1], a_lo[2], a_lo[3], a_hi[0], a_hi[1], a_hi[2], a_hi[3]};
        const bf16x8 vb2 = (bf16x8){b_lo[0], b_lo[1], b_lo[2], b_lo[3], b_hi[0], b_hi[1], b_hi[2], b_hi[3]};
        const bf16x8 pf = __builtin_bit_cast(bf16x8, pw[ks]);
        st.o0 = __builtin_amdgcn_mfma_f32_32x32x16_bf16(va, pf, st.o0, 0, 0, 0);
        st.o1 = __builtin_amdgcn_mfma_f32_32x32x16_bf16(vb2, pf, st.o1, 0, 0, 0);
    }
}

__device__ __forceinline__ void stage_o(const WaveState& st, float inv_l, LAS char* stg, int r32, int hi) {
#pragma unroll
    for (int g = 0; g < 4; ++g) {
        u32x2 w0, w1;
        w0.x = cvt_pk_bf16(st.o0[4 * g] * inv_l, st.o0[4 * g + 1] * inv_l); w0.y = cvt_pk_bf16(st.o0[4 * g + 2] * inv_l, st.o0[4 * g + 3] * inv_l);
        w1.x = cvt_pk_bf16(st.o1[4 * g] * inv_l, st.o1[4 * g + 1] * inv_l); w1.y = cvt_pk_bf16(st.o1[4 * g + 2] * inv_l, st.o1[4 * g + 3] * inv_l);
        *(LAS u32x2*)(stg + r32 * 128 + ((g ^ (r32 & 7)) * 16) + 8 * hi) = w0;
        *(LAS u32x2*)(stg + r32 * 128 + (((4 + g) ^ (r32 & 7)) * 16) + 8 * hi) = w1;
    }
}

struct Desc { int type, branch, dsh, res, lb, qb, jb, je; };
template <int NP>
__device__ __forceinline__ Desc get_desc(int u, int sub, const LAS int* js) {
    constexpr int DU = 12 / NP, BPB = 4 / NP;
    Desc q;
    if (u < DU) { q.type = 0; q.branch = u / BPB; const int blk = sub * BPB + (u - q.branch * BPB); q.dsh = 2 * q.branch; const int nlb = 32 >> q.dsh; q.res = blk >> (5 - q.dsh); q.lb = blk & (nlb - 1); q.qb = 0; q.jb = q.lb == 0 ? 2 : 0; q.je = 6; }
    else { q.type = 1; q.branch = 0; q.dsh = 0; q.res = 0; q.lb = 0; q.qb = sub + 8 * NP * (u - DU); q.jb = __builtin_amdgcn_readfirstlane(js[u - DU]); q.je = 4 * q.qb + 4; }
    return q;
}
__device__ __forceinline__ void wait_vm_bar(int c) {
    switch (c) { case 1: ATT_WAIT_BAR(1); break; case 2: ATT_WAIT_BAR(2); break; case 3: ATT_WAIT_BAR(3); break; case 4: ATT_WAIT_BAR(4); break; case 5: ATT_WAIT_BAR(5); break; case 6: ATT_WAIT_BAR(6); break; case 7: ATT_WAIT_BAR(7); break; case 8: ATT_WAIT_BAR(8); break; case 9: ATT_WAIT_BAR(9); break; case 10: ATT_WAIT_BAR(10); break; case 11: ATT_WAIT_BAR(11); break; case 12: ATT_WAIT_BAR(12); break; case 13: ATT_WAIT_BAR(13); break; case 14: ATT_WAIT_BAR(14); break; case 15: ATT_WAIT_BAR(15); break; case 16: ATT_WAIT_BAR(16); break; case 17: ATT_WAIT_BAR(17); break; case 18: ATT_WAIT_BAR(18); break; case 19: ATT_WAIT_BAR(19); break; case 20: ATT_WAIT_BAR(20); break; case 21: ATT_WAIT_BAR(21); break; case 22: ATT_WAIT_BAR(22); break; case 23: ATT_WAIT_BAR(23); break; case 24: ATT_WAIT_BAR(24); break; case 25: ATT_WAIT_BAR(25); break; case 26: ATT_WAIT_BAR(26); break; case 27: ATT_WAIT_BAR(27); break; case 28: ATT_WAIT_BAR(28); break; case 29: ATT_WAIT_BAR(29); break; case 30: ATT_WAIT_BAR(30); break; default: ATT_WAIT_BAR(0); break; }
}
__device__ __forceinline__ void wait_vm(int c) {
    switch (c) { case 1: asm volatile("s_waitcnt vmcnt(1)" ::: "memory"); break; case 2: asm volatile("s_waitcnt vmcnt(2)" ::: "memory"); break; case 3: asm volatile("s_waitcnt vmcnt(3)" ::: "memory"); break; case 4: asm volatile("s_waitcnt vmcnt(4)" ::: "memory"); break; case 5: asm volatile("s_waitcnt vmcnt(5)" ::: "memory"); break; case 6: asm volatile("s_waitcnt vmcnt(6)" ::: "memory"); break; case 7: asm volatile("s_waitcnt vmcnt(7)" ::: "memory"); break; case 8: asm volatile("s_waitcnt vmcnt(8)" ::: "memory"); break; case 9: asm volatile("s_waitcnt vmcnt(9)" ::: "memory"); break; case 10: asm volatile("s_waitcnt vmcnt(10)" ::: "memory"); break; case 11: asm volatile("s_waitcnt vmcnt(11)" ::: "memory"); break; case 12: asm volatile("s_waitcnt vmcnt(12)" ::: "memory"); break; case 13: asm volatile("s_waitcnt vmcnt(13)" ::: "memory"); break; case 14: asm volatile("s_waitcnt vmcnt(14)" ::: "memory"); break; case 15: asm volatile("s_waitcnt vmcnt(15)" ::: "memory"); break; case 16: asm volatile("s_waitcnt vmcnt(16)" ::: "memory"); break; case 17: asm volatile("s_waitcnt vmcnt(17)" ::: "memory"); break; case 18: asm volatile("s_waitcnt vmcnt(18)" ::: "memory"); break; case 19: asm volatile("s_waitcnt vmcnt(19)" ::: "memory"); break; case 20: asm volatile("s_waitcnt vmcnt(20)" ::: "memory"); break; case 21: asm volatile("s_waitcnt vmcnt(21)" ::: "memory"); break; case 22: asm volatile("s_waitcnt vmcnt(22)" ::: "memory"); break; case 23: asm volatile("s_waitcnt vmcnt(23)" ::: "memory"); break; case 24: asm volatile("s_waitcnt vmcnt(24)" ::: "memory"); break; case 25: asm volatile("s_waitcnt vmcnt(25)" ::: "memory"); break; case 26: asm volatile("s_waitcnt vmcnt(26)" ::: "memory"); break; case 27: asm volatile("s_waitcnt vmcnt(27)" ::: "memory"); break; case 28: asm volatile("s_waitcnt vmcnt(28)" ::: "memory"); break; case 29: asm volatile("s_waitcnt vmcnt(29)" ::: "memory"); break; case 30: asm volatile("s_waitcnt vmcnt(30)" ::: "memory"); break; default: if (c <= 0) asm volatile("s_waitcnt vmcnt(0)" ::: "memory"); else asm volatile("s_waitcnt vmcnt(30)" ::: "memory"); break; }
}
constexpr int L_C = 2 * NSLOT * SLOTB;
constexpr int L_TB3 = L_C + 2048;
constexpr int L_CTL = L_TB3 + 3 * 4 * TABN * 4;
constexpr int L_QS = L_CTL + 256;
constexpr int L_CQ = L_QS + 8 * 4096;

template <int PV, int ONLY, int NP>
__device__ __forceinline__ void attn_phase(int pass, int vcu, const bf16_t* qkv, bf16_t* og, float* lse, bf16_t* of, const float* cf2, const float* nrm, const float* rel_bias, LAS char* lds) {
    const int tid = threadIdx.x, lane = tid & 63, r32 = lane & 31, hi = lane >> 5; const int wid = __builtin_amdgcn_readfirstlane(tid >> 6);
    constexpr int S_ = 8 * NP, DU = 12 / NP, FU = 4 / NP;
    const int u0 = (ONLY == 1) ? DU : 0, u1 = (ONLY == 0) ? DU : DU + FU;
    const int bh = (vcu / S_) * NP + pass, sub = vcu % S_, b = bh >> 3, h = bh & 7;
    const bf16_t* QD = qkv; const bf16_t* KD = qkv + (size_t)1 * M * DH; const bf16_t* VD = qkv + (size_t)2 * M * DH;
    const bf16_t* QF = qkv + (size_t)3 * M * DH; const bf16_t* KF = qkv + (size_t)4 * M * DH; const bf16_t* VF = qkv + (size_t)5 * M * DH;
    const size_t rowb = (size_t)b * T;
    const float* cfh = cf2 + (size_t)bh * T;
    LAS float* tab = (LAS float*)(lds + L_TB3);
    LAS int* js = (LAS int*)(lds + L_CTL);
    const unsigned lds0 = (unsigned)(uintptr_t)lds;
    const int krow_ = 8 * wid + (lane >> 3), kch_ = (lane & 7) ^ ((krow_ >> 1) & 7);
    int kofs[4];
#pragma unroll
    for (int d0 = 0; d0 < 4; ++d0) kofs[d0] = r32 * 128 + (((2 * d0 + hi) ^ ((r32 >> 1) & 7)) * 16);
    if (ONLY != 1) { LAS float* rbh = (LAS float*)(lds + L_QS);
      if (tid < 32) rbh[tid] = rel_bias[tid * NH + h] * LOG2E;
      asm volatile("s_waitcnt vmcnt(0) lgkmcnt(0)" ::: "memory"); __builtin_amdgcn_s_barrier(); asm volatile("" ::: "memory");
      for (int idx = tid; idx < 3 * 4 * TABN; idx += 512) { const int br = idx / (4 * TABN), rem = idx - br * 4 * TABN, s = rem / TABN, u = rem - s * TABN, mm = 255 - (u + s);
        float v = NEGBIG; if (mm >= 0 && mm <= 128) v = rbh[(int)BUCKET[br][mm]];
        tab[idx] = v; } }
    if (ONLY != 0 && wid < FU) {
        const int qb = sub + 8 * NP * wid, jd = 4 * qb;
        const float* nq = nrm + ((size_t)0 * (M / 64) + (size_t)b * 128) * NH * 2;
        const float* nk = nrm + ((size_t)1 * (M / 64) + (size_t)b * 128) * NH * 2;
        float qm = 0.f, km = 0.f;
#pragma unroll
        for (int i = 0; i < 4; ++i) { const float* a = nq + ((size_t)(jd + i) * NH + h) * 2; const float* c_ = nk + ((size_t)(jd + i) * NH + h) * 2;
            qm = fmaxf(qm, a[0] + a[1]); km = fmaxf(km, c_[0] + c_[1]); }
        qm = sqrtf(qm); km = sqrtf(km);
        const float c_t0 = cfh[256 * qb];
        int jmin = jd;
#pragma unroll
        for (int half = 0; half < 2; ++half) { const int j = lane + 64 * half; bool keep = false;
            if (j < jd) { const float c_e = cfh[64 * j + 63]; const float* c_ = nk + ((size_t)j * NH + h) * 2; const float kn = sqrtf(c_[0] + c_[1]);
                const float ub = (c_t0 - c_e) + 1.02f * qm * (kn + km);
                keep = !(ub < -32.0f); }
            const unsigned long long bal = __ballot(keep);
            if (bal) { const int f = __ffsll((long long)bal) - 1 + 64 * half; jmin = f < jmin ? f : jmin; } }
        if (lane == 0) js[wid] = jmin;
    }
    asm volatile("s_waitcnt vmcnt(0) lgkmcnt(0)" ::: "memory"); __builtin_amdgcn_s_barrier(); asm volatile("" ::: "memory");
    int total = 0;
#pragma unroll 1
    for (int u = u0; u < u1; ++u) { const Desc q = get_desc<NP>(u, sub, js); total += q.je - q.jb; }
    int iu = u0, nis = 0, isl = 0; Desc iq = get_desc<NP>(u0, sub, js); int ij = iq.jb;
    const bf16_t* kb_; const bf16_t* vb_; const float* cb_; long tstr;
#define SET_ISSUE() do { if (iq.type == 0) { const int d_ = (PV == 6) ? 1 : (1 << iq.dsh); const int kl0 = 256 * iq.lb - 128; \
            kb_ = KD + (rowb + (long)(kl0 + krow_) * d_ + iq.res) * PITCH + h * HD + kch_ * 8; \
            vb_ = VD + (rowb + (long)(kl0 + 16 * (wid & 3) + (lane >> 2)) * d_ + iq.res) * PITCH + h * HD + (wid >> 2) * 32 + (lane & 3) * 8; \
            cb_ = cfh + lane; tstr = (long)64 * d_ * PITCH; } \
        else { kb_ = KF + (rowb + krow_) * PITCH + h * HD + kch_ * 8; vb_ = VF + (rowb + 16 * (wid & 3) + (lane >> 2)) * PITCH + h * HD + (wid >> 2) * 32 + (lane & 3) * 8; \
            cb_ = cfh + lane; tstr = (long)64 * PITCH; } } while (0)
#define ISSUE() do { if (iu < u1) { const int sl_ = isl; const int aj_ = iq.type ? (iq.je - 1 - (ij - iq.jb)) : ij; \
            glds16(kb_ + (long)aj_ * tstr, (unsigned)__builtin_amdgcn_readfirstlane(lds0 + L_K + sl_ * SLOTB + wid * 1024)); \
            glds16(vb_ + (long)aj_ * tstr, (unsigned)__builtin_amdgcn_readfirstlane(lds0 + L_V + sl_ * SLOTB + wid * 1024)); \
            glds4(cb_ + (iq.type ? 64 * aj_ : 0), (unsigned)__builtin_amdgcn_readfirstlane(lds0 + L_C + sl_ * 256)); \
            ++nis; isl = (isl == NSLOT - 1) ? 0 : isl + 1; ++ij; if (ij == iq.je) { ++iu; if (iu < u1) { iq = get_desc<NP>(iu, sub, js); ij = iq.jb; SET_ISSUE(); } } } } while (0)
    SET_ISSUE();
    int cu = u0; Desc cq_ = get_desc<NP>(u0, sub, js); int cj = cq_.jb;
#define QDMA(dq) do { const int rq_ = (dq.type == 0) ? ((256 * dq.lb + 32 * wid + r32) << dq.dsh) + dq.res : 256 * dq.qb + 32 * wid + r32; \
        const bf16_t* qrow_ = (dq.type == 0 ? QD : QF) + (rowb + rq_) * PITCH + h * HD + hi * 8; \
        _Pragma("unroll") for (int d0 = 0; d0 < 4; ++d0) glds16(qrow_ + d0 * 16, (unsigned)__builtin_amdgcn_readfirstlane(lds0 + L_QS + wid * 4096 + d0 * 1024)); \
        glds4(cfh + (dq.type ? rq_ : r32), (unsigned)__builtin_amdgcn_readfirstlane(lds0 + L_CQ + wid * 256)); } while (0)
#define QREAD(dq) do { _Pragma("unroll") for (int d0 = 0; d0 < 4; ++d0) qr[d0] = *(const LAS bf16x8*)(lds + L_QS + wid * 4096 + d0 * 1024 + lane * 16); \
        } while (0)
    bf16x8 qr[4];
    QDMA(cq_);
    asm volatile("s_waitcnt vmcnt(0)" ::: "memory");
    QREAD(cq_);
    asm volatile("s_waitcnt lgkmcnt(0)" ::: "memory");
    ISSUE(); ISSUE(); ISSUE(); ISSUE(); ISSUE();
    WaveState st; ws_reset(st); int started = 0;
    int extra = 0, qsteps = 0, csl = 0, nis_q = 0;
#pragma unroll 1
    for (int n = 0; n < total; ++n) {
        const int ahead = nis - 1 - n;
        if (PV < 2) { wait_vm_bar(3 * ahead + extra + (qsteps > 0 ? 5 : 0)); extra = 0; if (qsteps > 0) --qsteps;
        ISSUE(); } else { ATT_WAIT_BAR(0); if (iu < u1) { ++nis; isl = (isl == NSLOT - 1) ? 0 : isl + 1; ++ij; if (ij == iq.je) { ++iu; if (iu < u1) { iq = get_desc<NP>(iu, sub, js); ij = iq.jb; } } } }
        const bool lastt = (cj == cq_.je - 1);
        if (cj == cq_.jb && cu + 1 < u1) { const Desc nq_ = get_desc<NP>(cu + 1, sub, js); QDMA(nq_); qsteps = PF; nis_q = nis; }
        const int sl = csl; csl = (csl == NSLOT - 1) ? 0 : csl + 1;
        const int aj = cq_.type ? (cq_.je - 1 - (cj - cq_.jb)) : cj;
        if (ONLY != 1 && (ONLY == 0 || cq_.type == 0)) {
            const int wlo = wid >> 1;
            if (PV != 1 && PV != 5 && cj >= wlo && cj <= wlo + 2) {
                const int jj = cj - wlo; const int z0 = 127 - 32 * (wid & 1) - r32 + 64 * jj, s = z0 & 3;
                const LAS float* tb = tab + (cq_.branch * 4 + s) * TABN + (z0 - s);
                tile_compute<false, PV>((lds_cptr)(lds + L_K + sl * SLOTB), kofs, (lds_cptr)(lds + L_V + sl * SLOTB), qr, tb, false, 0, 0, st, started, r32, hi, lane);
            }
        } else if (ONLY != 0) {
            const int qfirst = 256 * cq_.qb + 32 * wid;
            if (PV != 1 && PV != 5 && 64 * aj <= qfirst + 31) {
                const bool band = (64 * aj + 63 > qfirst);
                tile_compute<true, PV>((lds_cptr)(lds + L_K + sl * SLOTB), kofs, (lds_cptr)(lds + L_V + sl * SLOTB), qr, (const LAS float*)(lds + L_C + sl * 256), band, qfirst + r32, 64 * aj, st, started, r32, hi, lane);
            }
        }
        ++cj;
        if (lastt) {
            float lt = st.l; { auto rr = __builtin_amdgcn_permlane32_swap(__float_as_uint(lt), __float_as_uint(lt), false, false); lt = __uint_as_float(rr[0]) + __uint_as_float(rr[1]); }
            const Desc od = cq_;
            ++cu;
            if (cu < u1) { cq_ = get_desc<NP>(cu, sub, js); cj = cq_.jb;
                wait_vm(3 * (nis - nis_q));
                QREAD(cq_); }
            asm volatile("s_waitcnt lgkmcnt(0)" ::: "memory");
            LAS char* stg = lds + L_QS + wid * 4096;
            stage_o(st, 1.0f / lt, stg, r32, hi);
            asm volatile("s_waitcnt lgkmcnt(0)" ::: "memory");
            { const int rsub = lane >> 3, c16 = lane & 7;
#pragma unroll
              for (int i = 0; i < 4; ++i) { const int rw = i * 8 + rsub; const u32x4 v = *(const LAS u32x4*)(stg + rw * 128 + ((c16 ^ (rw & 7)) * 16));
                if (od.type == 0) { const size_t orow = rowb + (((size_t)(256 * od.lb + 32 * wid + rw)) << od.dsh) + od.res; *(u32x4*)(og + ((size_t)od.branch * M + orow) * PITCH + h * HD + c16 * 8) = v; }
                else { *(u32x4*)(of + (rowb + 256 * od.qb + 32 * wid + rw) * PITCH + h * HD + c16 * 8) = v; } } }
            if (od.type == 0) { const size_t orow = rowb + (((size_t)(256 * od.lb + 32 * wid + r32)) << od.dsh) + od.res;
                if (hi == 0) lse[((size_t)od.branch * M + orow) * NH + h] = st.mref + __builtin_amdgcn_logf(lt);
                extra = 5; } else { extra = 4; }
            asm volatile("s_waitcnt lgkmcnt(0)" ::: "memory");
            ws_reset(st); started = 0;
        }
    }
#undef SET_ISSUE
#undef ISSUE
#undef QDMA
#undef QREAD
    asm volatile("s_waitcnt vmcnt(0) lgkmcnt(0)\n\ts_barrier" ::: "memory");
}
}
constexpr int NWAVES = 8;
constexpr size_t MiB = 1u << 20;
constexpr size_t WS_CTL = 0, CTL_ZERO_BYTES = 1 * MiB;
constexpr size_t WS_RSTD1 = 1 * MiB;
constexpr size_t WS_CTOT = WS_RSTD1 + 128 * 1024;
constexpr size_t WS_NRM = WS_CTOT + 8 * 1024;
constexpr size_t WS_WR = WS_NRM + 64 * 1024;
constexpr size_t WS_CL = 2 * MiB;
constexpr size_t WS_LSE = 3 * MiB;
constexpr size_t WS_WIN = 6 * MiB;
constexpr size_t WS_WOUT = 12 * MiB;
constexpr size_t WS_WGU = 14 * MiB;
constexpr size_t WS_WD = 46 * MiB;
constexpr size_t WS_LTOK = 62 * MiB, WS_LW = 66 * MiB, WS_LRS = 70 * MiB;
constexpr size_t WS_CF2 = 74 * MiB;
constexpr size_t WS_XB = 76 * MiB;
constexpr size_t WS_QKV = 140 * MiB;
constexpr size_t WS_OG = 332 * MiB;
constexpr size_t WS_OF = 428 * MiB;
constexpr size_t WS_H = 332 * MiB;
constexpr size_t WS_X1B = 370 * MiB;
constexpr size_t WS_END = 460 * MiB;
constexpr int CW_BAR = 4096;
constexpr int CW_ECNT = 16384;

constexpr int RING_BYTES = 131072;
constexpr int MISC_OFF = 163840 - 2048;
constexpr int LDS_BYTES = 163840;

#define RLX_AGENT __ATOMIC_RELAXED, __HIP_MEMORY_SCOPE_AGENT

#define XB_TMO      128
#define XB_XCNT(j)  (256  + 64 * (j))
#define XB_XSUB(j)  (1280 + 64 * (j))
#define XB_XGEN(j)  (2304 + 64 * (j))
#define XB_TOP      3328
#define XB_TOPGEN   3392
#define XCD_BAR_WORDS 3456
#define XB_SPIN_CAP (1u << 18)
__device__ __forceinline__ unsigned xb_ld(unsigned* p)              { return __hip_atomic_load(p, __ATOMIC_RELAXED, __HIP_MEMORY_SCOPE_AGENT); }
__device__ __forceinline__ unsigned xb_add(unsigned* p, unsigned v) { return __hip_atomic_fetch_add(p, v, __ATOMIC_RELAXED, __HIP_MEMORY_SCOPE_AGENT); }
__device__ __forceinline__ unsigned xb_xcc_id() { return (unsigned)__builtin_amdgcn_s_getreg((3 << 11) | 20) & 0xFu; }
#define XB_SPIN(cond, bar) do { unsigned _sp = 0; while (cond) { __builtin_amdgcn_s_sleep(1); \
    if ((++_sp & 255u) == 0u) { if (xb_ld(&(bar)[XB_TMO])) break; if (_sp > XB_SPIN_CAP) { atomicAdd(&(bar)[XB_TMO], 1u); break; } } } } while (0)
struct XcdBarrier { unsigned* bar; unsigned x; volatile LAS unsigned* st; };
__device__ __forceinline__ XcdBarrier xcd_barrier_post(unsigned* bar, volatile LAS unsigned* st) {
    XcdBarrier b; b.bar = bar; b.x = xb_xcc_id(); b.st = st;
    if (threadIdx.x == 0) (void)xb_add(&bar[XB_XCNT(b.x)], 1u);
    return b;
}
__device__ __forceinline__ void xcd_barrier_complete(unsigned* bar, unsigned x, unsigned& nloc, unsigned& nx) {
    const unsigned G = gridDim.x * gridDim.y * gridDim.z;
    unsigned sum, cnt, mine, sp = 0u;
    for (;;) {
        sum = 0u; cnt = 0u; mine = 0u;
#pragma unroll
        for (unsigned j = 0; j < 16; ++j) { const unsigned c = xb_ld(&bar[XB_XCNT(j)]); sum += c; cnt += (c > 0u) ? 1u : 0u; mine = (j == x) ? c : mine; }
        if (sum == G) break;
        __builtin_amdgcn_s_sleep(1);
        if ((++sp & 255u) == 0u) { if (xb_ld(&bar[XB_TMO])) break; if (sp > XB_SPIN_CAP) { atomicAdd(&bar[XB_TMO], 1u); break; } }
    }
    nloc = mine > 0u ? mine : 1u; nx = cnt > 0u ? cnt : 1u;
}
__device__ __forceinline__ void xcd_barrier(const XcdBarrier& b) {
    asm volatile("s_waitcnt vmcnt(0)" ::: "memory");
    __syncthreads();
    if (threadIdx.x == 0) {
        unsigned* bar = b.bar;
        __builtin_amdgcn_s_waitcnt(0);
        unsigned nloc = b.st[0], nx = b.st[1];
        if (nloc == 0u) { xcd_barrier_complete(bar, b.x, nloc, nx); b.st[0] = nloc; b.st[1] = nx; }
        const unsigned old = xb_add(&bar[XB_XSUB(b.x)], 1u);
        const unsigned gen = old / nloc;
        if (old + 1u == (gen + 1u) * nloc) {
            __builtin_amdgcn_fence(__ATOMIC_RELEASE, "agent");
            asm volatile("s_waitcnt vmcnt(0)" ::: "memory");
            const unsigned og = xb_add(&bar[XB_TOP], 1u);
            const unsigned tg = og / nx;
            if (og + 1u == (tg + 1u) * nx) xb_add(&bar[XB_TOPGEN], 1u);
            else XB_SPIN(xb_ld(&bar[XB_TOPGEN]) == tg, bar);
            __builtin_amdgcn_fence(__ATOMIC_ACQUIRE, "agent");
            xb_add(&bar[XB_XGEN(b.x)], 1u);
            asm volatile("s_waitcnt vmcnt(0)" ::: "memory");
        } else {
            XB_SPIN(xb_ld(&bar[XB_XGEN(b.x)]) == gen, bar);
            __builtin_amdgcn_fence(__ATOMIC_ACQUIRE, "agent");
            asm volatile("s_waitcnt vmcnt(0)" ::: "memory");
        }
    }
    __syncthreads();
}

__device__ __forceinline__ float wave_sum(float v) {
#pragma unroll
    for (int o = 1; o < 64; o <<= 1) v += __shfl_xor(v, o);
    return v;
}

struct TItem { const float* Wc; const float* gain; bf16_t* WT; int ldn, k0, ldk, dest_row0, mode; };
__device__ __forceinline__ void p0_titem_load(const TItem& t, float (&v)[32], int lane) {
    const float* src = t.Wc + (size_t)(t.k0 + (lane >> 5)) * t.ldn + (lane & 31);
#pragma unroll
    for (int i = 0; i < 32; ++i) v[i] = src[(size_t)(2 * i) * t.ldn];
}
__device__ __forceinline__ void p0_titem_store(const TItem& t, float (&v)[32], LAS float* scr, int lane) {
    if (t.gain) {
#pragma unroll
        for (int i = 0; i < 32; ++i) v[i] *= t.gain[t.k0 + 2 * i + (lane >> 5)]; }
#pragma unroll
    for (int i = 0; i < 32; ++i) scr[(2 * i + (lane >> 5)) * 33 + (lane & 31)] = v[i];
    asm volatile("s_waitcnt lgkmcnt(0)" ::: "memory");
    const int c = lane & 7;
#pragma unroll
    for (int j = 0; j < 4; ++j) { const int n = (lane >> 3) + 8 * j; const LAS float* s = scr + (8 * c) * 33 + n;
        u32x4 o; o.x = cvt_pk_bf16(s[0 * 33], s[1 * 33]); o.y = cvt_pk_bf16(s[2 * 33], s[3 * 33]); o.z = cvt_pk_bf16(s[4 * 33], s[5 * 33]); o.w = cvt_pk_bf16(s[6 * 33], s[7 * 33]);
        int drow = t.dest_row0 + n; if (t.mode == 1) { const int oc = drow; drow = (oc & ~255) + 128 * ((oc >> 3) & 1) + 32 * ((oc >> 6) & 3) + 8 * ((oc >> 4) & 3) + (oc & 7); }
        *(u32x4*)(t.WT + (size_t)drow * t.ldk + t.k0 + 8 * c) = o; }
    asm volatile("s_waitcnt lgkmcnt(0)" ::: "memory");
}

struct Args { const float* in[17]; float* out; unsigned char* ws; int ph_lo, ph_hi; };

#ifndef MK_SKIP_MOE
#define MK_SKIP_MOE 0
#endif
constexpr int N_PHASES = 9;

__global__ void __launch_bounds__(NWAVES * 64, 2) hymba_fwd(Args args) {
    extern __shared__ __attribute__((aligned(16))) unsigned char lds_raw[];
    LAS unsigned char* lds = (LAS unsigned char*)lds_raw;
    const int tid = threadIdx.x, lane = tid & 63; const int wave = __builtin_amdgcn_readfirstlane(tid >> 6);
    const int G = gridDim.x; const int bx = blockIdx.x; const int vcu = (G % 8 == 0) ? (bx % 8) * (G / 8) + bx / 8 : bx;
    unsigned char* ws = args.ws;
    unsigned* ctl = (unsigned*)(ws + WS_CTL);
    const float* x = args.in[0]; const float* w_in = args.in[1]; const float* b_forget = args.in[2]; const float* attn_norm = args.in[3];
    const float* on_dil = args.in[4]; const float* on_fox = args.in[5]; const float* w_out = args.in[6]; const float* ffn_norm = args.in[7];
    const float* w_rg = args.in[8]; const float* b_rg = args.in[9]; const float* w_re = args.in[10]; const float* b_re = args.in[11];
    const float* w_gate = args.in[12]; const float* w_up = args.in[13]; const float* w_down = args.in[14]; const float* rel_bias = args.in[15]; const float* final_norm = args.in[16];
    float* rstd1 = (float*)(ws + WS_RSTD1); float* ctot = (float*)(ws + WS_CTOT); float* nrm = (float*)(ws + WS_NRM); bf16_t* WrT = (bf16_t*)(ws + WS_WR);
    float* cl = (float*)(ws + WS_CL); float* lse = (float*)(ws + WS_LSE); float* cf2 = (float*)(ws + WS_CF2);
    bf16_t* WinT = (bf16_t*)(ws + WS_WIN); bf16_t* WoutT = (bf16_t*)(ws + WS_WOUT); bf16_t* WguT = (bf16_t*)(ws + WS_WGU); bf16_t* WdT = (bf16_t*)(ws + WS_WD);
    int* list_tok = (int*)(ws + WS_LTOK); float* list_w = (float*)(ws + WS_LW); float* list_rs = (float*)(ws + WS_LRS);
    bf16_t* xb = (bf16_t*)(ws + WS_XB); bf16_t* On = (bf16_t*)(ws + WS_XB);
    bf16_t* qkv = (bf16_t*)(ws + WS_QKV); unsigned char* yslot = (unsigned char*)(ws + WS_QKV);
    bf16_t* og = (bf16_t*)(ws + WS_OG); bf16_t* of = (bf16_t*)(ws + WS_OF); bf16_t* Hb = (bf16_t*)(ws + WS_H); bf16_t* x1b = (bf16_t*)(ws + WS_X1B);

    for (int u = tid; u < (LDS_BYTES - MISC_OFF) / 4; u += NWAVES * 64) ((LAS unsigned*)(lds + MISC_OFF))[u] = 0u;
    __syncthreads();
    const int lo = args.ph_lo, hi_ph = args.ph_hi;
    const bool one_launch = (hi_ph - lo) > 1;
    XcdBarrier bar; bar.bar = ctl + CW_BAR; bar.x = 0; bar.st = nullptr;
    if (one_launch) bar = xcd_barrier_post(ctl + CW_BAR, (volatile LAS unsigned*)(lds + MISC_OFF));
#ifndef PHASE_MASK
#define PHASE_MASK 0x1ff
#endif
#define IN(k) (((PHASE_MASK >> (k)) & 1) && lo <= (k) && (k) < hi_ph)
#define SEAM(k) do { if (IN(k) && IN((k) + 1)) xcd_barrier(bar); } while (0)

    if (IN(0)) {
        {
        LAS float* scr = (LAS float*)(lds + wave * 8704);
        const int gw = vcu * NWAVES + wave, NGW = G * NWAVES;
        constexpr int I_IN = 16 * 96, I_OUT = 16 * 32, I_G = NE * 16 * 8, I_D = NE * 4 * 32;
        constexpr int NIT = I_IN + I_OUT + 2 * I_G + I_D;
#define MK_ITEM(it_, T_) do { int r = (it_); \
            if (r < I_IN) { const int kb = r / 96, nb = r % 96; T_ = TItem{w_in + 32 * nb, attn_norm, WinT, DIN, 64 * kb, D, 32 * nb, 0}; } \
            else if ((r -= I_IN) < I_OUT) { const int kb = r / 32, nb = r % 32; T_ = TItem{w_out + 32 * nb, (kb < 8) ? on_dil : on_fox - DH, WoutT, D, 64 * kb, D, 32 * nb, 0}; } \
            else if ((r -= I_OUT) < 2 * I_G) { const int up = r >= I_G; if (up) r -= I_G; const int e = r / 128, q = r % 128, kb = q / 8, nb = q % 8, n0 = 32 * nb; \
                T_ = TItem{(up ? w_up : w_gate) + (size_t)e * D * DE + n0, ffn_norm, WguT + (size_t)e * 512 * D, DE, 64 * kb, D, (n0 >> 7) * 256 + up * 128 + (n0 & 127), 0}; } \
            else { r -= 2 * I_G; const int e = r / 128, q = r % 128, kb = q / 32, nb = q % 32; \
                T_ = TItem{w_down + (size_t)e * DE * D + 32 * nb, nullptr, WdT + (size_t)e * D * DE, D, 64 * kb, DE, 32 * nb, 1}; } } while (0)
        for (int it = gw; it < NIT; it += 2 * NGW) {
            TItem ta, tb2; float va[32], vb[32];
            MK_ITEM(it, ta); p0_titem_load(ta, va, lane);
            const bool two = (it + NGW < NIT);
            if (two) { MK_ITEM(it + NGW, tb2); p0_titem_load(tb2, vb, lane); }
            p0_titem_store(ta, va, scr, lane);
            if (two) p0_titem_store(tb2, vb, scr, lane);
        }
#undef MK_ITEM
        for (int it = gw * 64 + lane; it < 48 * 128; it += NGW * 64) { const int n = it >> 7, k8 = (it & 127) * 8; float v[8];
#pragma unroll
            for (int q = 0; q < 8; ++q) { const int k = k8 + q; float w = 0.f; if (n < 32) w = w_re[(size_t)k * NE + n]; else if (n < 36) w = w_rg[(size_t)k * NG + (n - 32)]; v[q] = w * ffn_norm[k]; }
            u32x4 o; o.x = cvt_pk_bf16(v[0], v[1]); o.y = cvt_pk_bf16(v[2], v[3]); o.z = cvt_pk_bf16(v[4], v[5]); o.w = cvt_pk_bf16(v[6], v[7]);
            *(u32x4*)(WrT + (size_t)n * D + k8) = o; }
        }
        __syncthreads();
        LAS unsigned short* wfh = (LAS unsigned short*)(lds); LAS unsigned short* wfl = (LAS unsigned short*)(lds + 32768);
        for (int i = tid; i < 4096; i += NWAVES * 64) ((LAS u32x4*)lds)[i] = (u32x4){0u, 0u, 0u, 0u};
        __syncthreads();
        for (int k = tid; k < D; k += NWAVES * 64) { const float gk = attn_norm[k]; const f32x4 a = *(const f32x4*)(w_in + (size_t)k * DIN + NQKV) * gk, b2 = *(const f32x4*)(w_in + (size_t)k * DIN + NQKV + 4) * gk;
            const int ent = ((k >> 5) * 4 + ((k >> 3) & 3)) * 16, j = k & 7;
#pragma unroll
            for (int c = 0; c < 8; ++c) { const float v = c < 4 ? a[c] : b2[c - 4]; const unsigned hw = cvt_pk_bf16(v, 0.f) & 0xffffu; const float hf = __builtin_bit_cast(float, hw << 16);
                const unsigned lw = cvt_pk_bf16(v - hf, 0.f) & 0xffffu; wfh[(ent + c) * 8 + j] = (unsigned short)hw; wfl[(ent + c) * 8 + j] = (unsigned short)lw; } }
        __syncthreads();
        {
        LAS float* lf = (LAS float*)(lds + 65536);
        LAS float* segs = lf + 1024;
        LAS float* rsl = segs + 128 + wave * 16;
        for (int ch = bx; ch < M / 128; ch += G) {
            const int rl = lane & 15, g_ = lane >> 4; const size_t row = (size_t)ch * 128 + wave * 16 + rl;
            const float* xr = x + row * D + 8 * g_; bf16_t* xo = xb + row * D + 8 * g_;
            f32x4 acc = (f32x4){0.f, 0.f, 0.f, 0.f}; float ss = 0.f;
#pragma unroll 8
            for (int kk = 0; kk < 32; ++kk) {
                const f32x4 v0 = *(const f32x4*)(xr + 32 * kk), v1 = *(const f32x4*)(xr + 32 * kk + 4);
                ss += (v0.x * v0.x + v0.y * v0.y) + (v0.z * v0.z + v0.w * v0.w) + (v1.x * v1.x + v1.y * v1.y) + (v1.z * v1.z + v1.w * v1.w);
                u32x4 hw; hw.x = cvt_pk_bf16(v0.x, v0.y); hw.y = cvt_pk_bf16(v0.z, v0.w); hw.z = cvt_pk_bf16(v1.x, v1.y); hw.w = cvt_pk_bf16(v1.z, v1.w);
                *(u32x4*)(xo + 32 * kk) = hw;
                u32x4 lw; lw.x = cvt_pk_bf16(v0.x - bf_lo(hw.x), v0.y - bf_hi(hw.x)); lw.y = cvt_pk_bf16(v0.z - bf_lo(hw.y), v0.w - bf_hi(hw.y));
                lw.z = cvt_pk_bf16(v1.x - bf_lo(hw.z), v1.y - bf_hi(hw.z)); lw.w = cvt_pk_bf16(v1.z - bf_lo(hw.w), v1.w - bf_hi(hw.w));
                const bf16x8 ah = __builtin_bit_cast(bf16x8, hw), al = __builtin_bit_cast(bf16x8, lw);
                const bf16x8 bh = *(const LAS bf16x8*)(lds + (((kk * 4 + g_) * 16 + rl) * 16)), bl = *(const LAS bf16x8*)(lds + 32768 + (((kk * 4 + g_) * 16 + rl) * 16));
                acc = __builtin_amdgcn_mfma_f32_16x16x32_bf16(ah, bh, acc, 0, 0, 0);
                acc = __builtin_amdgcn_mfma_f32_16x16x32_bf16(al, bh, acc, 0, 0, 0);
                acc = __builtin_amdgcn_mfma_f32_16x16x32_bf16(ah, bl, acc, 0, 0, 0);
            }
            ss += __shfl_xor(ss, 16); ss += __shfl_xor(ss, 32);
            const float rs = 1.0f / sqrtf(ss * (1.0f / D) + EPS);
            if (lane < 16) { rsl[lane] = rs; rstd1[row] = rs; }
            asm volatile("s_waitcnt lgkmcnt(0)" ::: "memory");
            if (rl < 8) { const float bfv = b_forget[rl];
#pragma unroll
                for (int i = 0; i < 4; ++i) { const float z = acc[i] * rsl[4 * g_ + i] + bfv; lf[(wave * 16 + 4 * g_ + i) * 8 + rl] = fminf(z, 0.f) - log1pf(expf(-fabsf(z))); } }
            __syncthreads();
            if (tid < 128) { const int hh = tid & 7, sg = tid >> 3; float s = 0.f;
#pragma unroll
                for (int i = 0; i < 8; ++i) { s += lf[(sg * 8 + i) * 8 + hh]; lf[(sg * 8 + i) * 8 + hh] = s; }
                segs[sg * 8 + hh] = s; }
            __syncthreads();
            if (tid < 8) { float s = 0.f;
#pragma unroll
                for (int i = 0; i < 16; ++i) { const float t_ = segs[i * 8 + tid]; segs[i * 8 + tid] = s; s += t_; }
                ctot[(size_t)ch * 8 + tid] = s; }
            __syncthreads();
            for (int i = tid; i < 1024; i += NWAVES * 64) { const int r_ = i >> 3, hh = i & 7; cl[((size_t)ch * 128 + r_) * 8 + hh] = lf[i] + segs[(r_ >> 3) * 8 + hh]; }
            __syncthreads();
        }
        }
    }
    SEAM(0);

    if (IN(1)) {
        { LAS float* part = (LAS float*)(lds);
          for (int ch = bx; ch < M / 128; ch += G) { const int b_ = ch >> 6, jc = ch & 63, j_ = tid >> 3, hh = tid & 7;
            float v = (j_ < jc) ? ctot[((size_t)b_ * 64 + j_) * NH + hh] : 0.f;
            v += __shfl_xor(v, 8); v += __shfl_xor(v, 16); v += __shfl_xor(v, 32);
            if (lane < 8) part[wave * 8 + lane] = v;
            __syncthreads();
            for (int i = tid; i < 1024; i += NWAVES * 64) { const int h2 = i >> 7, r_ = i & 127; float pre = 0.f;
#pragma unroll
                for (int w_ = 0; w_ < 8; ++w_) pre += part[w_ * 8 + h2];
                cf2[((size_t)b_ * NH + h2) * T + jc * 128 + r_] = (cl[((size_t)ch * 128 + r_) * NH + h2] + pre) * LOG2E; }
            __syncthreads(); } }
        pg8::Gemm g{xb, WinT, M, NQKV, D}; pg8::StaticOrder S; S.init(M, NQKV, G, bx);
        epi::EpiQKV E{qkv, rstd1, nrm};
        pg8::gemm_phase<epi::EpiQKV, pg8::StaticOrder, false>(lds, g, S, E);
    }
    SEAM(1);

    if (IN(2)) {
#ifndef ATT_NP
#define ATT_NP 1
#endif
#pragma unroll 1
        for (int ps = 0; ps < ATT_NP; ++ps) att::attn_phase<0, 0, ATT_NP>(ps, vcu, qkv, og, lse, of, cf2, nrm, rel_bias, (LAS char*)lds);
#pragma unroll 1
        for (int ps = 0; ps < ATT_NP; ++ps) att::attn_phase<0, 1, ATT_NP>(ps, vcu, qkv, og, lse, of, cf2, nrm, rel_bias, (LAS char*)lds);
    }
    SEAM(2);

    if (IN(3)) {
        const int gw = vcu * NWAVES + wave, NGW = G * NWAVES;
        for (int row0 = gw; row0 < M; row0 += 2 * NGW) {
            float od[2][8], ofx[2][8]; float sd[2] = {0.f, 0.f}, sf[2] = {0.f, 0.f};
#pragma unroll
            for (int rr = 0; rr < 2; ++rr) { const int row = (row0 + rr * NGW < M) ? row0 + rr * NGW : row0;
                const int hd = lane >> 3;
                float l0 = lse[((size_t)0 * M + row) * NH + hd], l1 = lse[((size_t)1 * M + row) * NH + hd], l2 = lse[((size_t)2 * M + row) * NH + hd];
                const u32x4 a = *(const u32x4*)(og + ((size_t)0 * M + row) * DH + 8 * lane), b2 = *(const u32x4*)(og + ((size_t)1 * M + row) * DH + 8 * lane), c2 = *(const u32x4*)(og + ((size_t)2 * M + row) * DH + 8 * lane);
                const u32x4 f = *(const u32x4*)(of + (size_t)row * DH + 8 * lane);
                const float mx = fmaxf(l0, fmaxf(l1, l2));
                float e0 = __builtin_amdgcn_exp2f(l0 - mx), e1 = __builtin_amdgcn_exp2f(l1 - mx), e2 = __builtin_amdgcn_exp2f(l2 - mx);
                const float inv = 1.0f / (e0 + e1 + e2); e0 *= inv; e1 *= inv; e2 *= inv;
#pragma unroll
                for (int q = 0; q < 4; ++q) {
                    od[rr][2 * q] = e0 * bf_lo(a[q]) + e1 * bf_lo(b2[q]) + e2 * bf_lo(c2[q]); od[rr][2 * q + 1] = e0 * bf_hi(a[q]) + e1 * bf_hi(b2[q]) + e2 * bf_hi(c2[q]);
                    ofx[rr][2 * q] = bf_lo(f[q]); ofx[rr][2 * q + 1] = bf_hi(f[q]);
                    sd[rr] += od[rr][2 * q] * od[rr][2 * q] + od[rr][2 * q + 1] * od[rr][2 * q + 1]; sf[rr] += ofx[rr][2 * q] * ofx[rr][2 * q] + ofx[rr][2 * q + 1] * ofx[rr][2 * q + 1]; } }
#pragma unroll
            for (int o = 1; o < 64; o <<= 1) { sd[0] += __shfl_xor(sd[0], o); sd[1] += __shfl_xor(sd[1], o); sf[0] += __shfl_xor(sf[0], o); sf[1] += __shfl_xor(sf[1], o); }
#pragma unroll
            for (int rr = 0; rr < 2; ++rr) { const int row = (row0 + rr * NGW < M) ? row0 + rr * NGW : row0;
                const float rd = 1.0f / sqrtf(sd[rr] * (1.0f / DH) + EPS), rf = 1.0f / sqrtf(sf[rr] * (1.0f / DH) + EPS);
                u32x4 o1, o2;
#pragma unroll
                for (int q = 0; q < 4; ++q) { o1[q] = cvt_pk_bf16(od[rr][2 * q] * rd, od[rr][2 * q + 1] * rd); o2[q] = cvt_pk_bf16(ofx[rr][2 * q] * rf, ofx[rr][2 * q + 1] * rf); }
                *(u32x4*)(On + (size_t)row * D + 8 * lane) = o1; *(u32x4*)(On + (size_t)row * D + DH + 8 * lane) = o2; }
        }
    }
    SEAM(3);

    if (IN(4)) {
        pg8::Gemm g{On, WoutT, M, D, D}; pg8::StaticOrder S; S.init(M, D, G, bx);
        epi::EpiRes E{x, x1b};
        pg8::gemm_phase<epi::EpiRes, pg8::StaticOrder, false>(lds, g, S, E);
    }
    SEAM(4);

    if (IN(5) && !MK_SKIP_MOE) {
        for (int it = tid; it < 48 * 128; it += NWAVES * 64) { const int n = it >> 7, c8 = it & 127, kk = c8 >> 2, g_ = c8 & 3, cb = n >> 4, col = n & 15;
            *(LAS u32x4*)(lds + ((((kk * 3 + cb) * 4 + g_) * 16 + col) * 16)) = *(const u32x4*)(WrT + (size_t)n * D + c8 * 8); }
        LAS float* lg = (LAS float*)(lds + 98304 + wave * 3072);
        LAS int* hist = (LAS int*)(lds + 98304 + 8 * 3072);
        LAS int* gbase = hist + 32;
        __syncthreads();
        for (int ch = bx; ch < M / 128; ch += G) {
            if (tid < 32) hist[tid] = 0;
            const int rl = lane & 15, g_ = lane >> 4; const size_t row = (size_t)ch * 128 + wave * 16 + rl;
            const bf16_t* ar = x1b + row * D + 8 * g_;
            f32x4 acc[3]; acc[0] = (f32x4){0.f, 0.f, 0.f, 0.f}; acc[1] = acc[0]; acc[2] = acc[0];
            float ss = 0.f;
#pragma unroll 16
            for (int kk = 0; kk < 32; ++kk) {
                const bf16x8 a = *(const bf16x8*)(ar + 32 * kk);
                const u32x4 au = __builtin_bit_cast(u32x4, a);
#pragma unroll
                for (int q = 0; q < 4; ++q) { const float lo_ = bf_lo(au[q]), hi_ = bf_hi(au[q]); ss += lo_ * lo_ + hi_ * hi_; }
#pragma unroll
                for (int cb = 0; cb < 3; ++cb) { const bf16x8 bfr = *(const LAS bf16x8*)(lds + ((((kk * 3 + cb) * 4 + g_) * 16 + rl) * 16));
                    acc[cb] = __builtin_amdgcn_mfma_f32_16x16x32_bf16(a, bfr, acc[cb], 0, 0, 0); }
            }
            ss += __shfl_xor(ss, 16); ss += __shfl_xor(ss, 32);
            const float rs2 = 1.0f / sqrtf(ss * (1.0f / D) + EPS);
#pragma unroll
            for (int cb = 0; cb < 3; ++cb)
#pragma unroll
                for (int i = 0; i < 4; ++i) lg[(4 * g_ + i) * 48 + 16 * cb + rl] = acc[cb][i];
            __syncthreads();
            int e_a = 0, e_b = 0, pos_a = 0, pos_b = 0; float w_a = 0.f, w_b = 0.f;
            if (lane < 16) {
                const LAS float* lr = lg + lane * 48;
                float gl[4]; int gi = 0;
#pragma unroll
                for (int i = 0; i < 4; ++i) gl[i] = lr[32 + i] * rs2 + b_rg[i];
                float gm = gl[0];
#pragma unroll
                for (int i = 1; i < 4; ++i) if (gl[i] > gm) { gm = gl[i]; gi = i; }
                float gs = 0.f;
#pragma unroll
                for (int i = 0; i < 4; ++i) gs += expf(gl[i] - gm);
                const float g1 = 1.0f / gs;
                float v1 = -3.0e38f, v2 = -3.0e38f; int i1 = 0, i2 = 0;
#pragma unroll
                for (int i = 0; i < 8; ++i) { const float v = lr[gi * 8 + i] * rs2 + b_re[gi * 8 + i];
                    if (v > v1) { v2 = v1; i2 = i1; v1 = v; i1 = i; } else if (v > v2) { v2 = v; i2 = i; } }
                const float ed = expf(v2 - v1), ga = 1.0f / (1.0f + ed), gb = ed * ga;
                e_a = gi * 8 + i1; e_b = gi * 8 + i2; w_a = g1 * ga; w_b = g1 * gb;
                pos_a = __hip_atomic_fetch_add(hist + e_a, 1, __ATOMIC_RELAXED, __HIP_MEMORY_SCOPE_WORKGROUP); pos_b = __hip_atomic_fetch_add(hist + e_b, 1, __ATOMIC_RELAXED, __HIP_MEMORY_SCOPE_WORKGROUP);
            }
            __syncthreads();
            if (tid < 32) { const int c = hist[tid]; gbase[tid] = c ? (int)__hip_atomic_fetch_add(ctl + CW_ECNT + 64 * tid, (unsigned)c, RLX_AGENT) : 0; }
            __syncthreads();
            if (lane < 16) { const int tok = (int)row;
                const size_t ia = (size_t)e_a * CAP + gbase[e_a] + pos_a, ib = (size_t)e_b * CAP + gbase[e_b] + pos_b;
                list_tok[ia] = tok * 2; list_w[ia] = w_a; list_rs[ia] = rs2;
                list_tok[ib] = tok * 2 + 1; list_w[ib] = w_b; list_rs[ib] = rs2; }
            __syncthreads();
        }
    }
    SEAM(5);

#define MOE_PREFIX() do { LAS int* pre_ = (LAS int*)(lds + MISC_OFF + 64); LAS int* cnt_ = (LAS int*)(lds + MISC_OFF + 256); \
        if (tid == 0) { int s_ = 0; for (int e_ = 0; e_ < NE; ++e_) { const int c_ = (int)__hip_atomic_load(ctl + CW_ECNT + 64 * e_, RLX_AGENT); cnt_[e_] = c_; pre_[e_] = s_; s_ += (c_ + 255) >> 8; } pre_[NE] = s_; } \
        __syncthreads(); } while (0)

    if (IN(6) && !MK_SKIP_MOE) {
        MOE_PREFIX();
        const LAS int* pre = (const LAS int*)(lds + MISC_OFF + 64); const LAS int* cnt = (const LAS int*)(lds + MISC_OFF + 256);
        pg8::Gemm g{x1b, WguT, M, 512, D}; pg8::MoeOrder<1> S{pre, cnt, list_tok, G, vcu};
        epi::EpiGU E{Hb, list_rs, cnt};
        pg8::gemm_phase<epi::EpiGU, pg8::MoeOrder<1>, true>(lds, g, S, E);
    }
    SEAM(6);

    if (IN(7) && !MK_SKIP_MOE) {
        MOE_PREFIX();
        const LAS int* pre = (const LAS int*)(lds + MISC_OFF + 64); const LAS int* cnt = (const LAS int*)(lds + MISC_OFF + 256);
        pg8::Gemm g{Hb, WdT, M, D, DE}; pg8::MoeOrder<2> S{pre, cnt, list_tok, G, vcu};
        epi::EpiDown E{yslot, list_tok, list_w, cnt};
        pg8::gemm_phase<epi::EpiDown, pg8::MoeOrder<2>, false>(lds, g, S, E);
    }
    SEAM(7);

    if (IN(8)) {
        const int gw = vcu * NWAVES + wave, NGW = G * NWAVES;
        for (int row0 = gw; row0 < M; row0 += 2 * NGW) {
            float v[2][16]; float ss[2] = {0.f, 0.f};
#pragma unroll
            for (int rr = 0; rr < 2; ++rr) { const int row = (row0 + rr * NGW < M) ? row0 + rr * NGW : row0;
#pragma unroll
              for (int hf = 0; hf < 2; ++hf) {
                const size_t co = (size_t)hf * DH + 8 * lane;
                const u32x4 a = *(const u32x4*)(x1b + (size_t)row * D + co);
#if MK_SKIP_MOE
                const u32x2 y0 = (u32x2){0u, 0u}, y1 = y0;
#else
                const u32x2 y0 = *(const u32x2*)(yslot + ((size_t)row * 2) * D + co), y1 = *(const u32x2*)(yslot + ((size_t)row * 2 + 1) * D + co);
#endif
#pragma unroll
                for (int q = 0; q < 4; ++q) { const f32x2 e0 = (q & 1) ? __builtin_amdgcn_cvt_pk_f32_fp8((int)y0[q >> 1], true) : __builtin_amdgcn_cvt_pk_f32_fp8((int)y0[q >> 1], false);
                    const f32x2 e1 = (q & 1) ? __builtin_amdgcn_cvt_pk_f32_fp8((int)y1[q >> 1], true) : __builtin_amdgcn_cvt_pk_f32_fp8((int)y1[q >> 1], false);
                    const float lo_ = bf_lo(a[q]) + (e0.x + e1.x) * 0.0625f, hi_ = bf_hi(a[q]) + (e0.y + e1.y) * 0.0625f;
                    v[rr][hf * 8 + 2 * q] = lo_; v[rr][hf * 8 + 2 * q + 1] = hi_; ss[rr] += lo_ * lo_ + hi_ * hi_; }
              } }
#pragma unroll
            for (int o = 1; o < 64; o <<= 1) { ss[0] += __shfl_xor(ss[0], o); ss[1] += __shfl_xor(ss[1], o); }
#pragma unroll
            for (int rr = 0; rr < 2; ++rr) { const int row = (row0 + rr * NGW < M) ? row0 + rr * NGW : row0;
              const float rs = 1.0f / sqrtf(ss[rr] * (1.0f / D) + EPS);
#pragma unroll
              for (int hf = 0; hf < 2; ++hf) { const size_t co = (size_t)hf * DH + 8 * lane;
                const f32x4 g0 = *(const f32x4*)(final_norm + co), g1 = *(const f32x4*)(final_norm + co + 4);
                f32x4 o0, o1;
#pragma unroll
                for (int q = 0; q < 4; ++q) { o0[q] = v[rr][hf * 8 + q] * rs * g0[q]; o1[q] = v[rr][hf * 8 + 4 + q] * rs * g1[q]; }
                *(f32x4*)(args.out + (size_t)row * D + co) = o0; *(f32x4*)(args.out + (size_t)row * D + co + 4) = o1; } }
        }
    }
#undef IN
#undef SEAM
}

#ifndef MK_N_LAUNCHES
#define MK_N_LAUNCHES 1
#endif
extern "C" void kernel_launch(void* const* d_in, const int* in_sizes, int n_in, void* d_out, int out_size, void* d_ws, size_t ws_size, hipStream_t stream) {
    static int grid = 0;
    if (grid == 0) {
        if (n_in != 17 || in_sizes[0] != M * D || out_size != M * D || ws_size < WS_END) { fprintf(stderr, "kernel_launch: unexpected shapes (n_in %d in0 %d out %d ws %zu)\n", n_in, n_in > 0 ? in_sizes[0] : -1, out_size, ws_size); grid = -1; return; }
        int dev = 0, cus = 0, per_cu = 0;
        if (hipGetDevice(&dev) != hipSuccess || hipDeviceGetAttribute(&cus, hipDeviceAttributeMultiprocessorCount, dev) != hipSuccess) { grid = -1; return; }
        if (hipFuncSetAttribute((const void*)hymba_fwd, hipFuncAttributeMaxDynamicSharedMemorySize, LDS_BYTES) != hipSuccess) { fprintf(stderr, "kernel_launch: hipFuncSetAttribute failed\n"); grid = -1; return; }
        if (hipOccupancyMaxActiveBlocksPerMultiprocessor(&per_cu, (const void*)hymba_fwd, NWAVES * 64, LDS_BYTES) != hipSuccess || per_cu < 1) { fprintf(stderr, "kernel_launch: occupancy query says %d\n", per_cu); }
        (void)hipGetLastError();
        if (cus < 256) { fprintf(stderr, "kernel_launch: this kernel is built for the 256 CUs of MI355X (device reports %d)\n", cus); grid = -1; return; }
        grid = 256;
    }
    if (grid < 0) return;
    (void)hipMemsetAsync((char*)d_ws + WS_CTL, 0, CTL_ZERO_BYTES, stream);
    Args a{};
    for (int i = 0; i < 17; ++i) a.in[i] = (const float*)d_in[i];
    a.out = (float*)d_out; a.ws = (unsigned char*)d_ws;
#if MK_N_LAUNCHES == 1
    a.ph_lo = 0; a.ph_hi = N_PHASES;
    hipLaunchKernelGGL(hymba_fwd, dim3(grid), dim3(NWAVES * 64), LDS_BYTES, stream, a);
#else
    for (int p = 0; p < N_PHASES; ++p) { a.ph_lo = p; a.ph_hi = p + 1; hipLaunchKernelGGL(hymba_fwd, dim3(grid), dim3(NWAVES * 64), LDS_BYTES, stream, a); }
#endif
}
```

```cpp
#include <hip/hip_runtime.h>
#include <hip/hip_bf16.h>
#include <cstdio>
#include <cstdint>

#define GAS __attribute__((address_space(1)))
#define LAS __attribute__((address_space(3)))
typedef unsigned short bf16_t;
typedef short bf16x8 __attribute__((ext_vector_type(8)));
typedef short s16x4 __attribute__((ext_vector_type(4)));
typedef float f32x4 __attribute__((ext_vector_type(4)));
typedef float f32x2 __attribute__((ext_vector_type(2)));
typedef float f32x16 __attribute__((ext_vector_type(16)));
typedef unsigned u32x4 __attribute__((ext_vector_type(4)));
typedef unsigned u32x2 __attribute__((ext_vector_type(2)));
typedef __bf16 bf16x2_t __attribute__((ext_vector_type(2)));

constexpr int BATCH = 4, T = 8192, D = 1024, M = BATCH * T;
constexpr int NH = 8, HD = 64, DH = NH * HD;
constexpr int NQKV = 6 * DH;
constexpr int DIN = NQKV + NH;
constexpr int NE = 32, DE = 256, EPG = 8, NG = 4;
constexpr int CAP = M;
constexpr float EPS = 1e-6f;
constexpr float LOG2E = 1.4426950408889634f;
constexpr float C2 = 0.125f * LOG2E;
constexpr float NEGBIG = -1e30f;

__device__ __forceinline__ unsigned cvt_pk_bf16(float lo, float hi) { f32x2 v = {lo, hi}; bf16x2_t b = __builtin_convertvector(v, bf16x2_t); return __builtin_bit_cast(unsigned, b); }
__device__ __forceinline__ float bf_lo(unsigned w) { return __builtin_bit_cast(float, w << 16); }
__device__ __forceinline__ float bf_hi(unsigned w) { return __builtin_bit_cast(float, w & 0xffff0000u); }

namespace pg8 {
#define PG8_LAS __attribute__((address_space(3)))
constexpr int BM = 256, BK = 64, HALF = 128, HTB = HALF * BK * 2  , STAGE_BYTES = 8 * HTB, NXCD = 8, WGM = 8;

__host__ __device__ __forceinline__ int lds_byte(int r, int c) { const int st = (r >> 4) * 2 + (c >> 5), rr = r & 15, cc = c & 31, ob = rr * 64 + cc * 2; return st * 1024 + (ob ^ (((ob >> 9) & 1) << 5)); }
__host__ __device__ __forceinline__ void stage_rc(int b, int& R, int& C) { const int st = b / 1024, sb = b % 1024, swz = sb ^ (((sb >> 9) & 1) << 5); R = (st >> 1) * 16 + swz / 64; C = (st & 1) * 32 + (swz % 64) / 2; }
__host__ __device__ __forceinline__ int perm32(int rho) { const int n = rho >> 4, i = rho & 15; return 8 * (i >> 2) + 4 * n + (i & 3); }

struct Unit { int pm, pn, e, ti; };
struct Gemm { const bf16_t* A; const bf16_t* Bt; int M, N, K; };

struct StaticOrder {
    int nM, nN, nwg, G, c;
    __host__ __device__ void init(int M_, int N_, int G_, int c_) { nM = M_ / BM; nN = N_ / BM; nwg = nM * nN; G = G_; c = c_; }
    __host__ __device__ bool next(int i, Unit& u) const {
        const long L = (long)i * G + c; if (L >= nwg) return false;
        int wgid = (int)L; { const int q = nwg / NXCD, r = nwg % NXCD, xcd = wgid % NXCD, off = wgid / NXCD; wgid = (xcd < r ? xcd * (q + 1) : r * (q + 1) + (xcd - r) * q) + off; }
        const int nig = WGM * nN, gid = wgid / nig, fm = gid * WGM, gsz = (nM - fm) < WGM ? (nM - fm) : WGM;
        u.pm = fm + ((wgid % nig) % gsz); u.pn = (wgid % nig) / gsz; u.e = 0; u.ti = 0; return true;
    }
    __device__ __forceinline__ int row_token(const Unit&, int) const { return 0; }
};

template <int SH> struct MoeOrder {
    static constexpr int npn = 1 << SH;
    const PG8_LAS int* pre; const PG8_LAS int* cnt; const int* list_tok; int G, c;
    __device__ __forceinline__ bool next(int i, Unit& u) const {
        const int L = i * G + c, total = __builtin_amdgcn_readfirstlane(pre[32]);
        if (L >= total * npn) return false;
        const int tf = L >> SH, pn = L & (npn - 1);
        int e = 0;
#pragma unroll 1
        for (int k = 16; k >= 1; k >>= 1) { const int pv = __builtin_amdgcn_readfirstlane(pre[e + k]); if (pv <= tf) e += k; }
        const int pe = __builtin_amdgcn_readfirstlane(pre[e]);
        u.e = e; u.ti = tf - pe; u.pm = tf; u.pn = e * npn + pn; return true;
    }
    __device__ __forceinline__ int row_token(const Unit& u, int r) const { int idx = u.ti * 256 + r; idx = idx < cnt[u.e] ? idx : 0; return list_tok[(size_t)u.e * CAP + idx] >> 1; }
};

template <class Epi, class Sched, bool GATHER, bool ALIGN_EPI = true>
__device__ __forceinline__ void gemm_phase(PG8_LAS unsigned char* lds, const Gemm g, const Sched& S, const Epi& E) {
    const int tid = threadIdx.x, wid = __builtin_amdgcn_readfirstlane(tid >> 6), lane = tid & 63, wr = wid >> 2, wc = wid & 3, fr = lane & 15, fq = lane >> 4;
    const int K = g.K, nt = K / BK;
    unsigned voffA[2], voffB[2]; int RA[2], CA[2];
#pragma unroll
    for (int i = 0; i < 2; ++i) { int R, C; stage_rc(tid * 16 + i * 8192, R, C); const int Rb = Epi::PERM ? ((R & ~31) + perm32(R & 31)) : R;
        voffA[i] = (unsigned)(R * K + C) * 2u; voffB[i] = (unsigned)(Rb * K + C) * 2u; RA[i] = R; CA[i] = C; }
    const size_t kstep = (size_t)(BK * 2);
    const size_t hstep = (size_t)HALF * K * 2;
    const size_t tstep = 2 * hstep;
    const unsigned ldsw = (unsigned)wid * 1024u;
    const int aoff = lds_byte(wr * 64 + fr, fq * 8), boff = lds_byte(wc * 32 + fr, fq * 8);
#define PG8_SA(b, h) (((b) * 2 + (h)) * HTB)
#define PG8_SB(b, h) ((4 + (b) * 2 + (h)) * HTB)
#define PG8_STAGE(bufoff, gbase, voff) do { _Pragma("unroll") for (int _i = 0; _i < 2; ++_i) \
        __builtin_amdgcn_global_load_lds((const unsigned*)((const char*)(gbase) + (voff)[_i]), (PG8_LAS unsigned*)(lds + (bufoff) + ldsw + _i * 8192), 16, 0, 0); } while (0)
#define PG8_STAGE_A(bufoff, ap, h, offs) do { if constexpr (GATHER) { PG8_STAGE(bufoff, ap, offs[h]); } else { PG8_STAGE(bufoff, (ap) + (h) * hstep, voffA); } } while (0)
#define PG8_LDA(dst, b, h) do { _Pragma("unroll") for (int m = 0; m < 4; ++m) _Pragma("unroll") for (int k = 0; k < 2; ++k) dst[m][k] = *(const PG8_LAS bf16x8*)(lds + PG8_SA(b, h) + aoff + m * 2048 + k * 1024); } while (0)
#define PG8_LDB(dst, b, h) do { _Pragma("unroll") for (int n = 0; n < 2; ++n) _Pragma("unroll") for (int k = 0; k < 2; ++k) dst[n][k] = *(const PG8_LAS bf16x8*)(lds + PG8_SB(b, h) + boff + n * 2048 + k * 1024); } while (0)
#define PG8_MMA(ai, bj, At, Bt) do { __builtin_amdgcn_s_setprio(1); _Pragma("unroll") for (int m = 0; m < 4; ++m) _Pragma("unroll") for (int n = 0; n < 2; ++n) _Pragma("unroll") for (int k = 0; k < 2; ++k) \
        acc[ai][bj][m][n] = __builtin_amdgcn_mfma_f32_16x16x32_bf16(Bt[n][k], At[m][k], acc[ai][bj][m][n], 0, 0, 0); __builtin_amdgcn_s_setprio(0); } while (0)
#define PG8_WAIT_V(n) asm volatile("s_waitcnt vmcnt(" #n ")" ::: "memory")
#define PG8_WAIT_L(n) asm volatile("s_waitcnt lgkmcnt(" #n ")" ::: "memory")
#define PG8_BAR __builtin_amdgcn_s_barrier()
#define PG8_SCHED __builtin_amdgcn_sched_barrier(0)
#define PG8_GOFFS(u_, v_) do { if constexpr (GATHER) { _Pragma("unroll") for (int h_ = 0; h_ < 2; ++h_) _Pragma("unroll") for (int i_ = 0; i_ < 2; ++i_) \
        v_[h_][i_] = (unsigned)(S.row_token(u_, h_ * HALF + RA[i_]) * K + CA[i_]) * 2u; } } while (0)
    Unit cur, nxt; int ui = 0;
    if (!S.next(0, cur)) return;
    f32x4 acc[2][2][4][2];
#pragma unroll
    for (int a = 0; a < 2; ++a)
#pragma unroll
        for (int b = 0; b < 2; ++b)
#pragma unroll
            for (int m = 0; m < 4; ++m)
#pragma unroll
                for (int n = 0; n < 2; ++n) acc[a][b][m][n] = (f32x4){0.f, 0.f, 0.f, 0.f};
    bf16x8 At[4][2], B0[2][2], B1[2][2];
    unsigned vA[2][2] = {{0u, 0u}, {0u, 0u}}, nvA[2][2] = {{0u, 0u}, {0u, 0u}};
    PG8_GOFFS(cur, vA);
    const char* cA = GATHER ? (const char*)g.A : (const char*)g.A + (size_t)cur.pm * tstep; const char* cB = (const char*)g.Bt + (size_t)cur.pn * tstep;
    PG8_STAGE(PG8_SB(0, 0), cB, voffB); PG8_STAGE(PG8_SB(0, 1), cB + hstep, voffB); PG8_STAGE_A(PG8_SA(0, 0), cA, 0, vA); PG8_STAGE_A(PG8_SA(0, 1), cA, 1, vA);
    if (wr == 1) PG8_BAR;
    PG8_WAIT_V(2); PG8_BAR;
    PG8_STAGE(PG8_SB(1, 0), cB + kstep, voffB); PG8_STAGE_A(PG8_SA(1, 0), cA + kstep, 0, vA); PG8_STAGE(PG8_SB(1, 1), cB + hstep + kstep, voffB);
    PG8_WAIT_V(6); PG8_BAR;
    for (;;) {
        const bool has_next = S.next(ui + 1, nxt);
        if (has_next) { PG8_GOFFS(nxt, nvA); } else { if constexpr (GATHER) {
#pragma unroll
            for (int h_ = 0; h_ < 2; ++h_)
#pragma unroll
                for (int i_ = 0; i_ < 2; ++i_) nvA[h_][i_] = vA[h_][i_]; } }
        const char* nA = GATHER ? cA : (has_next ? (const char*)g.A + (size_t)nxt.pm * tstep : cA); const char* nB = has_next ? (const char*)g.Bt + (size_t)nxt.pn * tstep : cB;
#pragma unroll 1
        for (int t = 0; t < nt; t += 2) {
            const bool last = (t == nt - 2);
            const char* a1 = cA + (size_t)(t + 1) * kstep;
            const char* a2 = last ? nA : cA + (size_t)(t + 2) * kstep; const char* b2 = last ? nB : cB + (size_t)(t + 2) * kstep;
            const char* a3 = a2 + kstep; const char* b3 = b2 + kstep;
            unsigned sA[2][2];
#pragma unroll
            for (int h_ = 0; h_ < 2; ++h_)
#pragma unroll
                for (int i_ = 0; i_ < 2; ++i_) sA[h_][i_] = last ? nvA[h_][i_] : vA[h_][i_];
            PG8_LDB(B0, 0, 0); PG8_LDB(B1, 0, 1); PG8_SCHED; PG8_LDA(At, 0, 0); PG8_STAGE_A(PG8_SA(1, 1), a1, 1, vA);
            PG8_WAIT_V(8); PG8_WAIT_L(0); PG8_BAR; PG8_MMA(0, 0, At, B0); PG8_MMA(0, 1, At, B1); PG8_BAR; PG8_SCHED;
            PG8_LDA(At, 0, 1); PG8_STAGE(PG8_SB(0, 0), b2, voffB); PG8_STAGE(PG8_SB(0, 1), b2 + hstep, voffB); PG8_STAGE_A(PG8_SA(0, 0), a2, 0, sA);
            PG8_WAIT_V(8); PG8_WAIT_L(0); PG8_BAR; PG8_MMA(1, 0, At, B0); PG8_MMA(1, 1, At, B1); PG8_BAR; PG8_SCHED;
            PG8_LDB(B0, 1, 0); PG8_LDB(B1, 1, 1); PG8_SCHED; PG8_LDA(At, 1, 0); PG8_STAGE_A(PG8_SA(0, 1), a2, 1, sA);
            PG8_WAIT_V(8); PG8_WAIT_L(0); PG8_BAR; PG8_MMA(0, 0, At, B0); PG8_MMA(0, 1, At, B1); PG8_BAR; PG8_SCHED;
            PG8_LDA(At, 1, 1); PG8_STAGE(PG8_SB(1, 0), b3, voffB); PG8_STAGE(PG8_SB(1, 1), b3 + hstep, voffB); PG8_STAGE_A(PG8_SA(1, 0), a3, 0, sA);
            PG8_WAIT_V(8); PG8_WAIT_L(0); PG8_BAR; PG8_MMA(1, 0, At, B0); PG8_MMA(1, 1, At, B1); PG8_BAR; PG8_SCHED;
        }
        if constexpr (ALIGN_EPI) { if (wr == 0) PG8_BAR; }
        E(acc, cur, wr, wc, fr, fq);
        if (!has_next) break;
#pragma unroll
        for (int a = 0; a < 2; ++a)
#pragma unroll
            for (int b = 0; b < 2; ++b)
#pragma unroll
                for (int m = 0; m < 4; ++m)
#pragma unroll
                    for (int n = 0; n < 2; ++n) acc[a][b][m][n] = (f32x4){0.f, 0.f, 0.f, 0.f};
        cur = nxt; cA = nA; cB = nB; ++ui;
#pragma unroll
        for (int h_ = 0; h_ < 2; ++h_)
#pragma unroll
            for (int i_ = 0; i_ < 2; ++i_) vA[h_][i_] = nvA[h_][i_];
        if constexpr (ALIGN_EPI) { if (wr == 1) PG8_BAR; }
    }
    PG8_WAIT_V(0);
    if constexpr (!ALIGN_EPI) { if (wr == 0) PG8_BAR; }
    PG8_BAR;
#undef PG8_SA
#undef PG8_SB
#undef PG8_STAGE
#undef PG8_STAGE_A
#undef PG8_LDA
#undef PG8_LDB
#undef PG8_MMA
#undef PG8_WAIT_V
#undef PG8_WAIT_L
#undef PG8_BAR
#undef PG8_SCHED
#undef PG8_GOFFS
}
}
namespace epi {
using pg8::Unit;
__device__ __forceinline__ u32x4 pack8(f32x4 v0, f32x4 v1) { u32x4 w; w.x = cvt_pk_bf16(v0[0], v0[1]); w.y = cvt_pk_bf16(v0[2], v0[3]); w.z = cvt_pk_bf16(v1[0], v1[1]); w.w = cvt_pk_bf16(v1[2], v1[3]); return w; }

struct EpiQKV {
    static constexpr bool PERM = true;
    bf16_t* O; const float* rstd; float* nrm;
    __device__ __forceinline__ void operator()(const f32x4 (&acc)[2][2][4][2], const Unit& u, int wr, int wc, int fr, int fq) const {
        const int t = u.pn >> 1, cin = (u.pn & 1) * 256 + wc * 32 + 8 * fq;
        bf16_t* base = O + (size_t)t * ((size_t)M * DH);
        const float sc = (t == 0 || t == 3) ? C2 : 1.f;
        const bool do_n = (t == 3 || t == 4), dil = (t < 3);
        const int row0 = u.pm * 256 + wr * 64 + fr;
        float mx[2][2] = {{0.f, 0.f}, {0.f, 0.f}};
#pragma unroll
        for (int ai = 0; ai < 2; ++ai)
#pragma unroll
            for (int m = 0; m < 4; ++m) { const int r = row0 + ai * 128 + m * 16; const float rs = rstd[r] * sc;
                const int b_ = r >> 13, tt = r & (T - 1);
#pragma unroll
                for (int bj = 0; bj < 2; ++bj) { const f32x4 v0 = acc[ai][bj][m][0] * rs, v1 = acc[ai][bj][m][1] * rs;
                    const int c0 = cin + bj * 128, hd_ = c0 >> 6, dd = c0 & 63, bh_ = b_ * NH + hd_;
                    const size_t orow = dil ? ((size_t)(bh_ * 16 + (tt & 15)) * 512 + (tt >> 4)) : ((size_t)bh_ * T + tt);
                    *(u32x4*)(base + orow * HD + dd) = pack8(v0, v1);
                    if (do_n) { float s = (v0[0] * v0[0] + v0[1] * v0[1]) + (v0[2] * v0[2] + v0[3] * v0[3]) + (v1[0] * v1[0] + v1[1] * v1[1]) + (v1[2] * v1[2] + v1[3] * v1[3]);
                        s += __shfl_xor(s, 16); s += __shfl_xor(s, 32); mx[ai][bj] = fmaxf(mx[ai][bj], s); } } }
        if (do_n) {
#pragma unroll
            for (int ai = 0; ai < 2; ++ai)
#pragma unroll
                for (int bj = 0; bj < 2; ++bj) { float v = mx[ai][bj];
                    v = fmaxf(v, __shfl_xor(v, 1)); v = fmaxf(v, __shfl_xor(v, 2)); v = fmaxf(v, __shfl_xor(v, 4)); v = fmaxf(v, __shfl_xor(v, 8));
                    const int tile64 = u.pm * 4 + ai * 2 + wr, head = (u.pn & 1) * 4 + 2 * bj + (wc >> 1);
                    if ((threadIdx.x & 63) == 0) nrm[(((size_t)(t - 3) * (M / 64) + tile64) * NH + head) * 2 + (wc & 1)] = v; }
        }
    }
};

struct EpiRes {
    static constexpr bool PERM = true;
    const bf16_t* xb; bf16_t* x1b;
    __device__ __forceinline__ void operator()(const f32x4 (&acc)[2][2][4][2], const Unit& u, int wr, int wc, int fr, int fq) const {
        const int row0 = u.pm * 256 + wr * 64 + fr, col0 = u.pn * 256 + wc * 32 + 8 * fq;
#pragma unroll
        for (int ai = 0; ai < 2; ++ai)
#pragma unroll
            for (int m = 0; m < 4; ++m) { const size_t off = (size_t)(row0 + ai * 128 + m * 16) * D + col0;
#pragma unroll
                for (int bj = 0; bj < 2; ++bj) { const u32x4 xv = *(const u32x4*)(xb + off + bj * 128);
                    const f32x4 x0 = (f32x4){bf_lo(xv.x), bf_hi(xv.x), bf_lo(xv.y), bf_hi(xv.y)}, x1 = (f32x4){bf_lo(xv.z), bf_hi(xv.z), bf_lo(xv.w), bf_hi(xv.w)};
                    *(u32x4*)(x1b + off + bj * 128) = pack8(acc[ai][bj][m][0] + x0, acc[ai][bj][m][1] + x1); } if (m & 1) asm volatile("" ::: "memory"); }
    }
};

struct EpiGU {
    static constexpr bool PERM = true;
    bf16_t* H; const float* list_rs; const LAS int* cnt;
    __device__ __forceinline__ void operator()(const f32x4 (&acc)[2][2][4][2], const Unit& u, int wr, int wc, int fr, int fq) const {
        const int pn = u.pn & 1, col0 = pn * 128 + wc * 32 + 8 * fq, r0 = wr * 64 + fr, ne = cnt[u.e];
        float rsv[2][4];
#pragma unroll
        for (int ai = 0; ai < 2; ++ai)
#pragma unroll
            for (int m = 0; m < 4; ++m) { int idx = u.ti * 256 + r0 + ai * 128 + m * 16; idx = idx < ne ? idx : 0; rsv[ai][m] = list_rs[(size_t)u.e * CAP + idx]; }
#pragma unroll
        for (int ai = 0; ai < 2; ++ai)
#pragma unroll
            for (int m = 0; m < 4; ++m) { const int r = r0 + ai * 128 + m * 16; const float rs = rsv[ai][m];
                f32x4 hv[2];
#pragma unroll
                for (int n = 0; n < 2; ++n) { const f32x4 gt = acc[ai][0][m][n] * rs, up = acc[ai][1][m][n] * rs;
#pragma unroll
                    for (int q = 0; q < 4; ++q) { const float sg = gt[q] * __builtin_amdgcn_rcpf(1.f + __builtin_amdgcn_exp2f(-gt[q] * LOG2E)); hv[n][q] = sg * up[q]; } }
                *(u32x4*)(H + ((size_t)u.pm * 256 + r) * DE + col0) = pack8(hv[0], hv[1]); }
    }
};

struct EpiDown {
    static constexpr bool PERM = true;
    unsigned char* Y; const float* list_w; const LAS int* cnt;
    __device__ __forceinline__ void operator()(const f32x4 (&acc)[2][2][4][2], const Unit& u, int wr, int wc, int fr, int fq) const {
        const int pn = u.pn & 3, col0 = pn * 256 + wc * 64 + 16 * fq, r0 = wr * 64 + fr, ne = cnt[u.e];
        float wv[2][4];
#pragma unroll
        for (int ai = 0; ai < 2; ++ai)
#pragma unroll
            for (int m = 0; m < 4; ++m) { const int idx = u.ti * 256 + r0 + ai * 128 + m * 16; const int ic = idx < ne ? idx : 0; wv[ai][m] = list_w[(size_t)u.e * CAP + ic] * 16.0f; }
#pragma unroll
        for (int ai = 0; ai < 2; ++ai)
#pragma unroll
            for (int m = 0; m < 4; ++m) { const float w = wv[ai][m]; u32x4 o;
#pragma unroll
                for (int bj = 0; bj < 2; ++bj)
#pragma unroll
                    for (int n = 0; n < 2; ++n) { const f32x4 v = acc[ai][bj][m][n] * w; int pk = 0;
                        pk = __builtin_amdgcn_cvt_pk_fp8_f32(v[0], v[1], pk, false); pk = __builtin_amdgcn_cvt_pk_fp8_f32(v[2], v[3], pk, true); o[bj * 2 + n] = (unsigned)pk; }
                *(u32x4*)(Y + ((size_t)u.pm * 256 + r0 + ai * 128 + m * 16) * D + col0) = o; }
    }
};
}
namespace att {
constexpr int PITCH = DH;
constexpr int NSLOT = 6, SLOTB = 8192, PF = 5;
constexpr int L_K = 0, L_V = NSLOT * SLOTB, L_TAB = 2 * NSLOT * SLOTB;
constexpr int TABN = 336;
constexpr int L_CK = L_TAB + 8192;
constexpr int L_MISC = L_CK + 32768;
constexpr int L_END = L_MISC + 1024;
typedef LAS const char* lds_cptr;
typedef short v4i16_t __attribute__((ext_vector_type(4)));

__device__ const unsigned char BUCKET[3][132] = {
 {0,1,2,3,4,5,6,7,8,9,10,11,12,13,14,15,16,16,16,16,16,16,17,17,17,17,17,17,17,17,18,18,18,18,18,18,18,18,18,18,19,19,19,19,19,19,19,19,19,19,19,19,19,19,20,20,20,20,20,20,20,20,20,20,20,20,20,20,20,20,20,20,20,21,21,21,21,21,21,21,21,21,21,21,21,21,21,21,21,21,21,21,21,21,21,21,21,21,21,22,22,22,22,22,22,22,22,22,22,22,22,22,22,22,22,22,22,22,22,22,22,22,22,22,22,22,22,22,22,0,0,0},
 {0,4,8,12,16,16,17,17,18,18,19,19,19,19,20,20,20,20,20,21,21,21,21,21,21,22,22,22,22,22,22,22,22,22,23,23,23,23,23,23,23,23,23,23,23,23,24,24,24,24,24,24,24,24,24,24,24,24,24,24,24,24,25,25,25,25,25,25,25,25,25,25,25,25,25,25,25,25,25,25,25,25,25,26,26,26,26,26,26,26,26,26,26,26,26,26,26,26,26,26,26,26,26,26,26,26,26,26,26,26,26,26,26,27,27,27,27,27,27,27,27,27,27,27,27,27,27,27,27,0,0,0},
 {0,16,18,19,20,21,21,22,22,23,23,23,24,24,24,24,25,25,25,25,25,26,26,26,26,26,26,26,26,27,27,27,27,27,27,27,27,27,27,28,28,28,28,28,28,28,28,28,28,28,28,28,29,29,29,29,29,29,29,29,29,29,29,29,29,29,29,29,29,29,30,30,30,30,30,30,30,30,30,30,30,30,30,30,30,30,30,30,30,30,30,30,30,30,30,31,31,31,31,31,31,31,31,31,31,31,31,31,31,31,31,31,31,31,31,31,31,31,31,31,31,31,31,31,31,31,31,31,31,0,0,0}};

__device__ __forceinline__ int crow(int r, int hi) { return (r & 3) + 8 * (r >> 2) + 4 * hi; }
__device__ __forceinline__ s16x4 vtr(lds_cptr p) { return __builtin_bit_cast(s16x4, __builtin_amdgcn_ds_read_tr16_b64_v4i16((LAS v4i16_t*)p)); }
__device__ __forceinline__ void glds16(const void* gsrc, unsigned lds_dst) { unsigned keep;
    asm volatile("s_mov_b32 %0, m0\n\ts_mov_b32 m0, %2\n\ts_nop 0\n\tglobal_load_lds_dwordx4 %1, off\n\ts_mov_b32 m0, %0" : "=&s"(keep) : "v"(gsrc), "s"(lds_dst) : "memory"); }
__device__ __forceinline__ void glds4(const void* gsrc, unsigned lds_dst) { unsigned keep;
    asm volatile("s_mov_b32 %0, m0\n\ts_mov_b32 m0, %2\n\ts_nop 0\n\tglobal_load_lds_dword %1, off\n\ts_mov_b32 m0, %0" : "=&s"(keep) : "v"(gsrc), "s"(lds_dst) : "memory"); }
#define ATT_WAIT_BAR(N) asm volatile("s_waitcnt vmcnt(" #N ") lgkmcnt(0)\n\ts_barrier" ::: "memory")

__device__ __forceinline__ float max3f(float a, float b, float c) { float r; asm("v_max3_f32 %0, %1, %2, %3" : "=v"(r) : "v"(a), "v"(b), "v"(c)); return r; }
__device__ __forceinline__ float fadd_s(float a, float b) { float r; asm("v_add_f32_e32 %0, %1, %2" : "=v"(r) : "v"(a), "v"(b)); return r; }
struct WaveState { float mref, l; f32x16 o0, o1, negm; };
__device__ __forceinline__ void ws_reset(WaveState& st) { st.mref = 0.f; st.l = 0.f;
#pragma unroll
    for (int r = 0; r < 16; ++r) { st.o0[r] = 0.f; st.o1[r] = 0.f; st.negm[r] = 0.f; } }

template <bool SUB, int PVT = 0>
__device__ __forceinline__ void tile_compute(lds_cptr kslot, const int (&kofs)[4], lds_cptr vslot, const bf16x8 (&qr)[4], const LAS float* tb, bool band, int qpos, int kpos0,
                                             WaveState& st, int& started, int r32, int hi, int lane) {
    f32x16 p0, p1;
    const lds_cptr vb = vslot + ((lane >> 4) & 1) * 32 + (lane & 3) * 8 + (4 * hi + ((lane & 15) >> 2)) * 64;
    bf16x8 kf[8]; f32x4 tt[8];
#pragma unroll
    for (int d0 = 0; d0 < 4; ++d0) { kf[2 * d0] = *(const LAS bf16x8*)(kslot + kofs[d0]); kf[2 * d0 + 1] = *(const LAS bf16x8*)(kslot + kofs[d0] + 4096); }
#pragma unroll
    for (int g = 0; g < 4; ++g) { tt[2 * g] = *(const LAS f32x4*)(tb + 8 * g + 4 * hi); tt[2 * g + 1] = *(const LAS f32x4*)(tb + 32 + 8 * g + 4 * hi); }
    __builtin_amdgcn_sched_barrier(0);
    p0 = __builtin_amdgcn_mfma_f32_32x32x16_bf16(kf[0], qr[0], st.negm, 0, 0, 0);
    p1 = __builtin_amdgcn_mfma_f32_32x32x16_bf16(kf[1], qr[0], st.negm, 0, 0, 0);
#pragma unroll
    for (int d0 = 1; d0 < 4; ++d0) {
        p0 = __builtin_amdgcn_mfma_f32_32x32x16_bf16(kf[2 * d0], qr[d0], p0, 0, 0, 0);
        p1 = __builtin_amdgcn_mfma_f32_32x32x16_bf16(kf[2 * d0 + 1], qr[d0], p1, 0, 0, 0);
    }
    s16x4 vf[16];
#pragma unroll
    for (int ks = 0; ks < 4; ++ks) { vf[4 * ks] = vtr(vb + ks * 1024); vf[4 * ks + 1] = vtr(vb + ks * 1024 + 512); vf[4 * ks + 2] = vtr(vb + 4096 + ks * 1024); vf[4 * ks + 3] = vtr(vb + 4096 + ks * 1024 + 512); }
    __builtin_amdgcn_sched_barrier(0);
#pragma unroll
    for (int g = 0; g < 4; ++g) {
#pragma unroll
        for (int q = 0; q < 4; ++q) { if (SUB) { p0[4 * g + q] -= tt[2 * g][q]; p1[4 * g + q] -= tt[2 * g + 1][q]; } else { p0[4 * g + q] += tt[2 * g][q]; p1[4 * g + q] += tt[2 * g + 1][q]; } } }
    if (band) {
#pragma unroll
        for (int r = 0; r < 16; ++r) { const int kv = kpos0 + crow(r, hi); if (kv > qpos) p0[r] = NEGBIG; if (kv + 32 > qpos) p1[r] = NEGBIG; }
    }
    float rm, rm2;
    { rm = max3f(p0[0], p0[1], p1[0]); rm2 = max3f(p0[2], p0[3], p1[1]); rm = max3f(rm, p1[2], p1[3]);
#pragma unroll
      for (int r = 4; r < 16; r += 4) { rm = max3f(rm, p0[r], p0[r + 1]); rm2 = max3f(rm2, p0[r + 2], p0[r + 3]); rm = max3f(rm, p1[r], p1[r + 1]); rm2 = max3f(rm2, p1[r + 2], p1[r + 3]); }
      rm = fmaxf(rm, rm2); }
    { auto rr = __builtin_amdgcn_permlane32_swap(__float_as_uint(rm), __float_as_uint(rm), false, false); rm = fmaxf(__uint_as_float(rr[0]), __uint_as_float(rr[1])); }
    if (PVT == 3) { st.l += rm; return; }
    if (started && __all(rm < -32.0f)) return;
    started = 1;
    if (__any(rm > 8.0f)) {
        const float dl = fmaxf(rm, 0.f), f = __builtin_amdgcn_exp2f(-dl);
        st.mref += dl; st.l *= f;
#pragma unroll
        for (int r = 0; r < 16; ++r) { p0[r] -= dl; p1[r] -= dl; st.o0[r] *= f; st.o1[r] *= f; st.negm[r] = -st.mref; }
    }
#pragma unroll
    for (int r = 0; r < 16; ++r) { p0[r] = __builtin_amdgcn_exp2f(p0[r]); p1[r] = __builtin_amdgcn_exp2f(p1[r]); }
    { float sa = p0[0], sb = p1[0];
#pragma unroll
      for (int r = 1; r < 16; ++r) { sa += p0[r]; asm volatile("" : "+v"(sa)); sb += p1[r]; asm volatile("" : "+v"(sb)); }
      st.l += sa + sb; }
    u32x4 pw[4];
#pragma unroll
    for (int s = 0; s < 2; ++s)
#pragma unroll
        for (int j = 0; j < 4; ++j) { pw[s][j] = cvt_pk_bf16(p0[8 * s + 2 * j], p0[8 * s + 2 * j + 1]); pw[2 + s][j] = cvt_pk_bf16(p1[8 * s + 2 * j], p1[8 * s + 2 * j + 1]); }
    __builtin_amdgcn_sched_barrier(0);
#pragma unroll
    for (int ks = 0; ks < 4; ++ks) {
        const s16x4 a_lo = vf[4 * ks], a_hi = vf[4 * ks + 1], b_lo = vf[4 * ks + 2], b_hi = vf[4 * ks + 3];
        const bf16x8 va = (bf16x8){a_lo[0], a_lo[1], a_lo[2], a_lo[3], a_hi[0], a_hi[1], a_hi[2], a_hi[3]};
        const bf16x8 vb2 = (bf16x8){b_lo[0], b_lo[1], b_lo[2], b_lo[3], b_hi[0], b_hi[1], b_hi[2], b_hi[3]};
        const bf16x8 pf = __builtin_bit_cast(bf16x8, pw[ks]);
        st.o0 = __builtin_amdgcn_mfma_f32_32x32x16_bf16(va, pf, st.o0, 0, 0, 0);
        st.o1 = __builtin_amdgcn_mfma_f32_32x32x16_bf16(vb2, pf, st.o1, 0, 0, 0);
    }
}

__device__ __forceinline__ void stage_o(const WaveState& st, float inv_l, LAS char* stg, int r32, int hi) {
#pragma unroll
    for (int g = 0; g < 4; ++g) {
        u32x2 w0, w1;
        w0.x = cvt_pk_bf16(st.o0[4 * g] * inv_l, st.o0[4 * g + 1] * inv_l); w0.y = cvt_pk_bf16(st.o0[4 * g + 2] * inv_l, st.o0[4 * g + 3] * inv_l);
        w1.x = cvt_pk_bf16(st.o1[4 * g] * inv_l, st.o1[4 * g + 1] * inv_l); w1.y = cvt_pk_bf16(st.o1[4 * g + 2] * inv_l, st.o1[4 * g + 3] * inv_l);
        *(LAS u32x2*)(stg + r32 * 128 + ((g ^ (r32 & 7)) * 16) + 8 * hi) = w0;
        *(LAS u32x2*)(stg + r32 * 128 + (((4 + g) ^ (r32 & 7)) * 16) + 8 * hi) = w1;
    }
}

struct Desc { int type, branch, dsh, res, lb, qb, jb, je; };
template <int NP>
__device__ __forceinline__ Desc get_desc(int u, int sub, const LAS int* js) {
    constexpr int DU = 12 / NP, BPB = 4 / NP;
    Desc q;
    if (u < DU) { q.type = 0; q.branch = u / BPB; const int blk = sub * BPB + (u - q.branch * BPB); q.dsh = 2 * q.branch; const int nlb = 32 >> q.dsh; q.res = blk >> (5 - q.dsh); q.lb = blk & (nlb - 1); q.qb = 0; q.jb = q.lb == 0 ? 2 : 0; q.je = 6; }
    else { q.type = 1; q.branch = 0; q.dsh = 0; q.res = 0; q.lb = 0; q.qb = sub + 8 * NP * (u - DU); q.jb = __builtin_amdgcn_readfirstlane(js[u - DU]); q.je = 4 * q.qb + 4; }
    return q;
}
__device__ __forceinline__ void wait_vm_bar(int c) {
    switch (c) { case 1: ATT_WAIT_BAR(1); break; case 2: ATT_WAIT_BAR(2); break; case 3: ATT_WAIT_BAR(3); break; case 4: ATT_WAIT_BAR(4); break; case 5: ATT_WAIT_BAR(5); break; case 6: ATT_WAIT_BAR(6); break; case 7: ATT_WAIT_BAR(7); break; case 8: ATT_WAIT_BAR(8); break; case 9: ATT_WAIT_BAR(9); break; case 10: ATT_WAIT_BAR(10); break; case 11: ATT_WAIT_BAR(11); break; case 12: ATT_WAIT_BAR(12); break; case 13: ATT_WAIT_BAR(13); break; case 14: ATT_WAIT_BAR(14); break; case 15: ATT_WAIT_BAR(15); break; case 16: ATT_WAIT_BAR(16); break; case 17: ATT_WAIT_BAR(17); break; case 18: ATT_WAIT_BAR(18); break; case 19: ATT_WAIT_BAR(19); break; case 20: ATT_WAIT_BAR(20); break; case 21: ATT_WAIT_BAR(21); break; case 22: ATT_WAIT_BAR(22); break; case 23: ATT_WAIT_BAR(23); break; case 24: ATT_WAIT_BAR(24); break; case 25: ATT_WAIT_BAR(25); break; case 26: ATT_WAIT_BAR(26); break; case 27: ATT_WAIT_BAR(27); break; case 28: ATT_WAIT_BAR(28); break; case 29: ATT_WAIT_BAR(29); break; case 30: ATT_WAIT_BAR(30); break; default: ATT_WAIT_BAR(0); break; }
}
__device__ __forceinline__ void wait_vm(int c) {
    switch (c) { case 1: asm volatile("s_waitcnt vmcnt(1)" ::: "memory"); break; case 2: asm volatile("s_waitcnt vmcnt(2)" ::: "memory"); break; case 3: asm volatile("s_waitcnt vmcnt(3)" ::: "memory"); break; case 4: asm volatile("s_waitcnt vmcnt(4)" ::: "memory"); break; case 5: asm volatile("s_waitcnt vmcnt(5)" ::: "memory"); break; case 6: asm volatile("s_waitcnt vmcnt(6)" ::: "memory"); break; case 7: asm volatile("s_waitcnt vmcnt(7)" ::: "memory"); break; case 8: asm volatile("s_waitcnt vmcnt(8)" ::: "memory"); break; case 9: asm volatile("s_waitcnt vmcnt(9)" ::: "memory"); break; case 10: asm volatile("s_waitcnt vmcnt(10)" ::: "memory"); break; case 11: asm volatile("s_waitcnt vmcnt(11)" ::: "memory"); break; case 12: asm volatile("s_waitcnt vmcnt(12)" ::: "memory"); break; case 13: asm volatile("s_waitcnt vmcnt(13)" ::: "memory"); break; case 14: asm volatile("s_waitcnt vmcnt(14)" ::: "memory"); break; case 15: asm volatile("s_waitcnt vmcnt(15)" ::: "memory"); break; case 16: asm volatile("s_waitcnt vmcnt(16)" ::: "memory"); break; case 17: asm volatile("s_waitcnt vmcnt(17)" ::: "memory"); break; case 18: asm volatile("s_waitcnt vmcnt(18)" ::: "memory"); break; case 19: asm volatile("s_waitcnt vmcnt(19)" ::: "memory"); break; case 20: asm volatile("s_waitcnt vmcnt(20)" ::: "memory"); break; case 21: asm volatile("s_waitcnt vmcnt(21)" ::: "memory"); break; case 22: asm volatile("s_waitcnt vmcnt(22)" ::: "memory"); break; case 23: asm volatile("s_waitcnt vmcnt(23)" ::: "memory"); break; case 24: asm volatile("s_waitcnt vmcnt(24)" ::: "memory"); break; case 25: asm volatile("s_waitcnt vmcnt(25)" ::: "memory"); break; case 26: asm volatile("s_waitcnt vmcnt(26)" ::: "memory"); break; case 27: asm volatile("s_waitcnt vmcnt(27)" ::: "memory"); break; case 28: asm volatile("s_waitcnt vmcnt(28)" ::: "memory"); break; case 29: asm volatile("s_waitcnt vmcnt(29)" ::: "memory"); break; case 30: asm volatile("s_waitcnt vmcnt(30)" ::: "memory"); break; default: if (c <= 0) asm volatile("s_waitcnt vmcnt(0)" ::: "memory"); else asm volatile("s_waitcnt vmcnt(30)" ::: "memory"); break; }
}
constexpr int L_C = 2 * NSLOT * SLOTB;
constexpr int L_TB3 = L_C + 2048;
constexpr int L_CTL = L_TB3 + 3 * 4 * TABN * 4;
constexpr int L_QS = L_CTL + 256;
constexpr int L_CQ = L_QS + 8 * 4096;

template <int PV, int ONLY, int NP>
__device__ __forceinline__ void attn_phase(int pass, int vcu, const bf16_t* qkv, bf16_t* og, float* lse, bf16_t* of, const float* cf2, const float* nrm, const float* rel_bias, LAS char* lds) {
    const int tid = threadIdx.x, lane = tid & 63, r32 = lane & 31, hi = lane >> 5; const int wid = __builtin_amdgcn_readfirstlane(tid >> 6);
    constexpr int S_ = 8 * NP, DU = 12 / NP, FU = 4 / NP;
    const int u0 = (ONLY == 1) ? DU : 0, u1 = (ONLY == 0) ? DU : DU + FU;
    const int bh = (vcu / S_) * NP + pass, sub = vcu % S_, b = bh >> 3, h = bh & 7;
    const bf16_t* QD = qkv; const bf16_t* KD = qkv + (size_t)1 * M * DH; const bf16_t* VD = qkv + (size_t)2 * M * DH;
    const bf16_t* QF = qkv + (size_t)3 * M * DH; const bf16_t* KF = qkv + (size_t)4 * M * DH; const bf16_t* VF = qkv + (size_t)5 * M * DH;
    const size_t rowb = (size_t)b * T;
    const float* cfh = cf2 + (size_t)bh * T;
    LAS float* tab = (LAS float*)(lds + L_TB3);
    LAS int* js = (LAS int*)(lds + L_CTL);
    const unsigned lds0 = (unsigned)(uintptr_t)lds;
    const int krow_ = 8 * wid + (lane >> 3), kch_ = (lane & 7) ^ ((krow_ >> 1) & 7);
    int kofs[4];
#pragma unroll
    for (int d0 = 0; d0 < 4; ++d0) kofs[d0] = r32 * 128 + (((2 * d0 + hi) ^ ((r32 >> 1) & 7)) * 16);
    if (ONLY != 1) { LAS float* rbh = (LAS float*)(lds + L_QS);
      if (tid < 32) rbh[tid] = rel_bias[tid * NH + h] * LOG2E;
      asm volatile("s_waitcnt vmcnt(0) lgkmcnt(0)" ::: "memory"); __builtin_amdgcn_s_barrier(); asm volatile("" ::: "memory");
      for (int idx = tid; idx < 3 * 4 * TABN; idx += 512) { const int br = idx / (4 * TABN), rem = idx - br * 4 * TABN, s = rem / TABN, u = rem - s * TABN, mm = 255 - (u + s);
        float v = NEGBIG; if (mm >= 0 && mm <= 128) v = rbh[(int)BUCKET[br][mm]];
        tab[idx] = v; } }
    if (ONLY != 0 && wid < FU) {
        const int qb = sub + 8 * NP * wid, jd = 4 * qb;
        const float* nq = nrm + ((size_t)0 * (M / 64) + (size_t)b * 128) * NH * 2;
        const float* nk = nrm + ((size_t)1 * (M / 64) + (size_t)b * 128) * NH * 2;
        float qm = 0.f, km = 0.f;
#pragma unroll
        for (int i = 0; i < 4; ++i) { const float* a = nq + ((size_t)(jd + i) * NH + h) * 2; const float* c_ = nk + ((size_t)(jd + i) * NH + h) * 2;
            qm = fmaxf(qm, a[0] + a[1]); km = fmaxf(km, c_[0] + c_[1]); }
        qm = sqrtf(qm); km = sqrtf(km);
        const float c_t0 = cfh[256 * qb];
        int jmin = jd;
#pragma unroll
        for (int half = 0; half < 2; ++half) { const int j = lane + 64 * half; bool keep = false;
            if (j < jd) { const float c_e = cfh[64 * j + 63]; const float* c_ = nk + ((size_t)j * NH + h) * 2; const float kn = sqrtf(c_[0] + c_[1]);
                const float ub = (c_t0 - c_e) + 1.02f * qm * (kn + km);
                keep = !(ub < -32.0f); }
            const unsigned long long bal = __ballot(keep);
            if (bal) { const int f = __ffsll((long long)bal) - 1 + 64 * half; jmin = f < jmin ? f : jmin; } }
        if (lane == 0) js[wid] = jmin;
    }
    asm volatile("s_waitcnt vmcnt(0) lgkmcnt(0)" ::: "memory"); __builtin_amdgcn_s_barrier(); asm volatile("" ::: "memory");
    int total = 0;
#pragma unroll 1
    for (int u = u0; u < u1; ++u) { const Desc q = get_desc<NP>(u, sub, js); total += q.je - q.jb; }
    int iu = u0, nis = 0, isl = 0; Desc iq = get_desc<NP>(u0, sub, js); int ij = iq.jb;
    const bf16_t* kb_; const bf16_t* vb_; const float* cb_; long tstr;
    const size_t bhD = (size_t)bh * 16 * 512, bhF = (size_t)bh * T;
#define ROWD(t_) ((long)bhD + (long)((t_) & 15) * 512 + (long)((t_) >> 4))
#define SET_ISSUE() do { if (iq.type == 0) { const int d_ = (PV == 6) ? 1 : (1 << iq.dsh); const int kl0 = 256 * iq.lb - 128; \
            const int tk_ = (kl0 + krow_) * d_ + iq.res, tv_ = (kl0 + 16 * (wid & 3) + (lane >> 2)) * d_ + iq.res; \
            kb_ = KD + ROWD(tk_) * HD + kch_ * 8; \
            vb_ = VD + ROWD(tv_) * HD + (wid >> 2) * 32 + (lane & 3) * 8; \
            cb_ = cfh + lane; tstr = (long)4 * d_ * HD; } \
        else { kb_ = KF + ((long)bhF + krow_) * HD + kch_ * 8; vb_ = VF + ((long)bhF + 16 * (wid & 3) + (lane >> 2)) * HD + (wid >> 2) * 32 + (lane & 3) * 8; \
            cb_ = cfh + lane; tstr = (long)64 * HD; } } while (0)
#define ISSUE() do { if (iu < u1) { const int sl_ = isl; const int aj_ = iq.type ? (iq.je - 1 - (ij - iq.jb)) : ij; \
            glds16(kb_ + (long)aj_ * tstr, (unsigned)__builtin_amdgcn_readfirstlane(lds0 + L_K + sl_ * SLOTB + wid * 1024)); \
            glds16(vb_ + (long)aj_ * tstr, (unsigned)__builtin_amdgcn_readfirstlane(lds0 + L_V + sl_ * SLOTB + wid * 1024)); \
            glds4(cb_ + (iq.type ? 64 * aj_ : 0), (unsigned)__builtin_amdgcn_readfirstlane(lds0 + L_C + sl_ * 256)); \
            ++nis; isl = (isl == NSLOT - 1) ? 0 : isl + 1; ++ij; if (ij == iq.je) { ++iu; if (iu < u1) { iq = get_desc<NP>(iu, sub, js); ij = iq.jb; SET_ISSUE(); } } } } while (0)
    SET_ISSUE();
    int cu = u0; Desc cq_ = get_desc<NP>(u0, sub, js); int cj = cq_.jb;
#define QDMA(dq) do { const int rq_ = (dq.type == 0) ? ((256 * dq.lb + 32 * wid + r32) << dq.dsh) + dq.res : 256 * dq.qb + 32 * wid + r32; \
        const bf16_t* qrow_ = (dq.type == 0 ? QD + ROWD(rq_) * HD : QF + ((long)bhF + rq_) * HD) + hi * 8; \
        _Pragma("unroll") for (int d0 = 0; d0 < 4; ++d0) glds16(qrow_ + d0 * 16, (unsigned)__builtin_amdgcn_readfirstlane(lds0 + L_QS + wid * 4096 + d0 * 1024)); \
        glds4(cfh + (dq.type ? rq_ : r32), (unsigned)__builtin_amdgcn_readfirstlane(lds0 + L_CQ + wid * 256)); } while (0)
#define QREAD(dq) do { _Pragma("unroll") for (int d0 = 0; d0 < 4; ++d0) qr[d0] = *(const LAS bf16x8*)(lds + L_QS + wid * 4096 + d0 * 1024 + lane * 16); \
        } while (0)
    bf16x8 qr[4];
    QDMA(cq_);
    asm volatile("s_waitcnt vmcnt(0)" ::: "memory");
    QREAD(cq_);
    asm volatile("s_waitcnt lgkmcnt(0)" ::: "memory");
    ISSUE(); ISSUE(); ISSUE(); ISSUE(); ISSUE();
    WaveState st; ws_reset(st); int started = 0;
    int extra = 0, qsteps = 0, csl = 0, nis_q = 0;
#pragma unroll 1
    for (int n = 0; n < total; ++n) {
        const int ahead = nis - 1 - n;
        if (PV < 2) { wait_vm_bar(3 * ahead + extra + (qsteps > 0 ? 5 : 0)); extra = 0; if (qsteps > 0) --qsteps;
        ISSUE(); } else { ATT_WAIT_BAR(0); if (iu < u1) { ++nis; isl = (isl == NSLOT - 1) ? 0 : isl + 1; ++ij; if (ij == iq.je) { ++iu; if (iu < u1) { iq = get_desc<NP>(iu, sub, js); ij = iq.jb; } } } }
        const bool lastt = (cj == cq_.je - 1);
        if (cj == cq_.jb && cu + 1 < u1) { const Desc nq_ = get_desc<NP>(cu + 1, sub, js); QDMA(nq_); qsteps = PF; nis_q = nis; }
        const int sl = csl; csl = (csl == NSLOT - 1) ? 0 : csl + 1;
        const int aj = cq_.type ? (cq_.je - 1 - (cj - cq_.jb)) : cj;
        if (ONLY != 1 && (ONLY == 0 || cq_.type == 0)) {
            const int wlo = wid >> 1;
            if (PV != 1 && PV != 5 && cj >= wlo && cj <= wlo + 2) {
                const int jj = cj - wlo; const int z0 = 127 - 32 * (wid & 1) - r32 + 64 * jj, s = z0 & 3;
                const LAS float* tb = tab + (cq_.branch * 4 + s) * TABN + (z0 - s);
                tile_compute<false, PV>((lds_cptr)(lds + L_K + sl * SLOTB), kofs, (lds_cptr)(lds + L_V + sl * SLOTB), qr, tb, false, 0, 0, st, started, r32, hi, lane);
            }
        } else if (ONLY != 0) {
            const int qfirst = 256 * cq_.qb + 32 * wid;
            if (PV != 1 && PV != 5 && 64 * aj <= qfirst + 31) {
                const bool band = (64 * aj + 63 > qfirst);
                tile_compute<true, PV>((lds_cptr)(lds + L_K + sl * SLOTB), kofs, (lds_cptr)(lds + L_V + sl * SLOTB), qr, (const LAS float*)(lds + L_C + sl * 256), band, qfirst + r32, 64 * aj, st, started, r32, hi, lane);
            }
        }
        ++cj;
        if (lastt) {
            float lt = st.l; { auto rr = __builtin_amdgcn_permlane32_swap(__float_as_uint(lt), __float_as_uint(lt), false, false); lt = __uint_as_float(rr[0]) + __uint_as_float(rr[1]); }
            const Desc od = cq_;
            ++cu;
            if (cu < u1) { cq_ = get_desc<NP>(cu, sub, js); cj = cq_.jb;
                wait_vm(3 * (nis - nis_q));
                QREAD(cq_); }
            asm volatile("s_waitcnt lgkmcnt(0)" ::: "memory");
            LAS char* stg = lds + L_QS + wid * 4096;
            stage_o(st, 1.0f / lt, stg, r32, hi);
            asm volatile("s_waitcnt lgkmcnt(0)" ::: "memory");
            { const int rsub = lane >> 3, c16 = lane & 7;
#pragma unroll
              for (int i = 0; i < 4; ++i) { const int rw = i * 8 + rsub; const u32x4 v = *(const LAS u32x4*)(stg + rw * 128 + ((c16 ^ (rw & 7)) * 16));
                if (od.type == 0) { const size_t orow = rowb + (((size_t)(256 * od.lb + 32 * wid + rw)) << od.dsh) + od.res; *(u32x4*)(og + ((size_t)od.branch * M + orow) * PITCH + h * HD + c16 * 8) = v; }
                else { *(u32x4*)(of + (rowb + 256 * od.qb + 32 * wid + rw) * PITCH + h * HD + c16 * 8) = v; } } }
            if (od.type == 0) { const size_t orow = rowb + (((size_t)(256 * od.lb + 32 * wid + r32)) << od.dsh) + od.res;
                if (hi == 0) lse[((size_t)od.branch * M + orow) * NH + h] = st.mref + __builtin_amdgcn_logf(lt);
                extra = 5; } else { extra = 4; }
            asm volatile("s_waitcnt lgkmcnt(0)" ::: "memory");
            ws_reset(st); started = 0;
        }
    }
#undef ROWD
#undef SET_ISSUE
#undef ISSUE
#undef QDMA
#undef QREAD
    asm volatile("s_waitcnt vmcnt(0) lgkmcnt(0)\n\ts_barrier" ::: "memory");
}

__device__ __forceinline__ void dil_stream(int vcu, const bf16_t* qkv, bf16_t* og, float* lse, const float* cf2, const float* rel_bias, LAS char* lds) {
    const int tid = threadIdx.x, lane = tid & 63, r32 = lane & 31, hi = lane >> 5; const int wid = __builtin_amdgcn_readfirstlane(tid >> 6);
    constexpr int NU = 12;
    const int bh = vcu >> 3, sub = vcu & 7, b = bh >> 3, h = bh & 7, wlo = wid >> 1;
    const bf16_t* QD = qkv; const bf16_t* KD = qkv + (size_t)1 * M * DH; const bf16_t* VD = qkv + (size_t)2 * M * DH;
    const size_t rowb = (size_t)b * T;
    const float* cfh = cf2 + (size_t)bh * T;
    LAS float* tab = (LAS float*)(lds + L_TB3);
    const unsigned lds0 = (unsigned)(uintptr_t)lds;
    const int krow_ = 8 * wid + (lane >> 3), kch_ = (lane & 7) ^ ((krow_ >> 1) & 7);
    int kofs[4];
#pragma unroll
    for (int d0 = 0; d0 < 4; ++d0) kofs[d0] = r32 * 128 + (((2 * d0 + hi) ^ ((r32 >> 1) & 7)) * 16);
    { LAS float* rbh = (LAS float*)(lds + L_QS);
      if (tid < 32) rbh[tid] = rel_bias[tid * NH + h] * LOG2E;
      asm volatile("s_waitcnt vmcnt(0) lgkmcnt(0)" ::: "memory"); __builtin_amdgcn_s_barrier(); asm volatile("" ::: "memory");
      for (int idx = tid; idx < 3 * 4 * TABN; idx += 512) { const int br = idx / (4 * TABN), rem = idx - br * 4 * TABN, s = rem / TABN, u = rem - s * TABN, mm = 255 - (u + s);
        float v = NEGBIG; if (mm >= 0 && mm <= 128) v = rbh[(int)BUCKET[br][mm]];
        tab[idx] = v; } }
    asm volatile("s_waitcnt vmcnt(0) lgkmcnt(0)" ::: "memory"); __builtin_amdgcn_s_barrier(); asm volatile("" ::: "memory");
    const size_t bhD = (size_t)bh * 16 * 512;
#define ROWD(t_) ((long)bhD + (long)((t_) & 15) * 512 + (long)((t_) >> 4))
    int vm_issued = 0, vm_mark0 = 0, vm_mark1 = 0, vm_mark2 = 0, qmark = 0;
#define UDESC(u_, BR, DSH, RES, LB) const int BR = (u_) >> 2, DSH = 2 * BR, blk_##BR = sub * 4 + ((u_) & 3), RES = blk_##BR >> (5 - DSH), LB = blk_##BR & ((32 >> DSH) - 1)
#define ISSUE_TILE(u_, j_, sp_) do { if ((u_) >= 0 && (u_) < NU) { UDESC(u_, br_, dsh_, res_, lb_); if (!((lb_) == 0 && (j_) < 2)) { const int d_ = 1 << dsh_; const int kl_ = 256 * lb_ - 128 + 64 * (j_); \
            const int tk_ = (kl_ + krow_) * d_ + res_, tv_ = (kl_ + 16 * (wid & 3) + (lane >> 2)) * d_ + res_; \
            glds16(KD + ROWD(tk_) * HD + kch_ * 8, (unsigned)__builtin_amdgcn_readfirstlane(lds0 + L_K + (sp_) * SLOTB + wid * 1024)); \
            glds16(VD + ROWD(tv_) * HD + (wid >> 2) * 32 + (lane & 3) * 8, (unsigned)__builtin_amdgcn_readfirstlane(lds0 + L_V + (sp_) * SLOTB + wid * 1024)); \
            vm_issued += 2; } } } while (0)
#define ISSUE_STEP(k_) do { const int k3_ = (k_) % 3, ku_ = (k_) / 3; ISSUE_TILE(ku_, k3_, 2 * k3_); ISSUE_TILE(ku_ - 1, k3_ + 3, 2 * k3_ + 1); \
        if (k3_ == 0) vm_mark0 = vm_issued; else if (k3_ == 1) vm_mark1 = vm_issued; else vm_mark2 = vm_issued; } while (0)
#define QDMA_U(u_) do { UDESC(u_, brq_, dshq_, resq_, lbq_); const int rq_ = ((256 * lbq_ + 32 * wid + r32) << dshq_) + resq_; \
        const bf16_t* qrow_ = QD + ROWD(rq_) * HD + hi * 8; \
        _Pragma("unroll") for (int d0 = 0; d0 < 4; ++d0) glds16(qrow_ + d0 * 16, (unsigned)__builtin_amdgcn_readfirstlane(lds0 + L_QS + wid * 4096 + d0 * 1024)); \
        vm_issued += 4; qmark = vm_issued; } while (0)
    bf16x8 qr[4];
    QDMA_U(0);
    ISSUE_STEP(0); ISSUE_STEP(1);
    WaveState st; ws_reset(st); int started = 0;
    constexpr int NSTEP = 3 * NU + 4;
#pragma unroll 1
    for (int k = 0; k < NSTEP; ++k) {
        const int k3 = k % 3;
        { const int mk = (k3 == 0) ? vm_mark0 : (k3 == 1) ? vm_mark1 : vm_mark2; int c = vm_issued - mk; c = c > 30 ? 30 : c; wait_vm_bar(c); }
        if (k + 2 < NSTEP) ISSUE_STEP(k + 2);
        const bool isA = (wlo <= k3); const int u = isA ? k / 3 : k / 3 - 1; const int j = isA ? k3 : k3 + 3; const int jj = j - wlo; const int sp = 2 * k3 + (isA ? 0 : 1);
        if (jj == 0) {
            if (u > 0 && u <= NU) {
                UDESC(u - 1, bro_, dsho_, reso_, lbo_);
                float lt = st.l; { auto rr = __builtin_amdgcn_permlane32_swap(__float_as_uint(lt), __float_as_uint(lt), false, false); lt = __uint_as_float(rr[0]) + __uint_as_float(rr[1]); }
                const float il = 1.0f / lt;
                const size_t orow = rowb + (((size_t)(256 * lbo_ + 32 * wid + r32)) << dsho_) + reso_;
                bf16_t* op = og + ((size_t)bro_ * M + orow) * PITCH + h * HD;
#pragma unroll
                for (int g = 0; g < 4; ++g) { u32x2 w0, w1;
                    w0.x = cvt_pk_bf16(st.o0[4 * g] * il, st.o0[4 * g + 1] * il); w0.y = cvt_pk_bf16(st.o0[4 * g + 2] * il, st.o0[4 * g + 3] * il);
                    w1.x = cvt_pk_bf16(st.o1[4 * g] * il, st.o1[4 * g + 1] * il); w1.y = cvt_pk_bf16(st.o1[4 * g + 2] * il, st.o1[4 * g + 3] * il);
                    *(u32x2*)(op + 8 * g + 4 * hi) = w0; *(u32x2*)(op + 32 + 8 * g + 4 * hi) = w1; }
                lse[((size_t)bro_ * M + orow) * NH + h] = st.mref + __builtin_amdgcn_logf(lt);
                vm_issued += 9;
                ws_reset(st); started = 0;
            }
            if (u >= 0 && u < NU) {
                { int c = vm_issued - qmark; wait_vm(c > 30 ? 30 : c); }
#pragma unroll
                for (int d0 = 0; d0 < 4; ++d0) qr[d0] = *(const LAS bf16x8*)(lds + L_QS + wid * 4096 + d0 * 1024 + lane * 16);
                asm volatile("s_waitcnt lgkmcnt(0)" ::: "memory");
                if (u + 1 < NU) QDMA_U(u + 1);
            }
        }
        if (u >= 0 && u < NU) {
            UDESC(u, brc_, dshc_, resc_, lbc_);
            if (!(lbc_ == 0 && j < 2)) {
                const int z0 = 127 - 32 * (wid & 1) - r32 + 64 * jj, s = z0 & 3;
                const LAS float* tb = tab + (brc_ * 4 + s) * TABN + (z0 - s);
                tile_compute<false, 0>((lds_cptr)(lds + L_K + sp * SLOTB), kofs, (lds_cptr)(lds + L_V + sp * SLOTB), qr, tb, false, 0, 0, st, started, r32, hi, lane);
            }
        }
    }
#undef ROWD
#undef UDESC
#undef ISSUE_TILE
#undef ISSUE_STEP
#undef QDMA_U
    asm volatile("s_waitcnt vmcnt(0) lgkmcnt(0)\n\ts_barrier" ::: "memory");
}
}
constexpr int NWAVES = 8;
constexpr size_t MiB = 1u << 20;
constexpr size_t WS_CTL = 0, CTL_ZERO_BYTES = 1 * MiB;
constexpr size_t WS_RSTD1 = 1 * MiB;
constexpr size_t WS_CTOT = WS_RSTD1 + 128 * 1024;
constexpr size_t WS_NRM = WS_CTOT + 8 * 1024;
constexpr size_t WS_WR = WS_NRM + 64 * 1024;
constexpr size_t WS_CL = 2 * MiB;
constexpr size_t WS_LSE = 3 * MiB;
constexpr size_t WS_WIN = 6 * MiB;
constexpr size_t WS_WOUT = 12 * MiB;
constexpr size_t WS_WGU = 14 * MiB;
constexpr size_t WS_WD = 46 * MiB;
constexpr size_t WS_LTOK = 62 * MiB, WS_LW = 66 * MiB, WS_LRS = 70 * MiB;
constexpr size_t WS_TMAP = 75 * MiB;
constexpr size_t WS_CF2 = 74 * MiB;
constexpr size_t WS_XB = 76 * MiB;
constexpr size_t WS_QKV = 140 * MiB;
constexpr size_t WS_ON = 204 * MiB;
constexpr size_t WS_OG = 332 * MiB;
constexpr size_t WS_OF = 428 * MiB;
constexpr size_t WS_H = 332 * MiB;
constexpr size_t WS_X1B = 370 * MiB;
constexpr size_t WS_END = 460 * MiB;
constexpr int CW_BAR = 4096;
constexpr int CW_ECNT = 16384;

constexpr int RING_BYTES = 131072;
constexpr int MISC_OFF = 163840 - 2048;
constexpr int LDS_BYTES = 163840;

#define RLX_AGENT __ATOMIC_RELAXED, __HIP_MEMORY_SCOPE_AGENT

#define XB_TMO      128
#define XB_XCNT(j)  (256  + 64 * (j))
#define XB_XSUB(j)  (1280 + 64 * (j))
#define XB_XGEN(j)  (2304 + 64 * (j))
#define XB_TOP      3328
#define XB_TOPGEN   3392
#define XCD_BAR_WORDS 3456
#define XB_SPIN_CAP (1u << 18)
__device__ __forceinline__ unsigned xb_ld(unsigned* p)              { return __hip_atomic_load(p, __ATOMIC_RELAXED, __HIP_MEMORY_SCOPE_AGENT); }
__device__ __forceinline__ unsigned xb_add(unsigned* p, unsigned v) { return __hip_atomic_fetch_add(p, v, __ATOMIC_RELAXED, __HIP_MEMORY_SCOPE_AGENT); }
__device__ __forceinline__ unsigned xb_xcc_id() { return (unsigned)__builtin_amdgcn_s_getreg((3 << 11) | 20) & 0xFu; }
#define XB_SPIN(cond, bar) do { unsigned _sp = 0; while (cond) { __builtin_amdgcn_s_sleep(1); \
    if ((++_sp & 255u) == 0u) { if (xb_ld(&(bar)[XB_TMO])) break; if (_sp > XB_SPIN_CAP) { atomicAdd(&(bar)[XB_TMO], 1u); break; } } } } while (0)
struct XcdBarrier { unsigned* bar; unsigned x; volatile LAS unsigned* st; };
__device__ __forceinline__ XcdBarrier xcd_barrier_post(unsigned* bar, volatile LAS unsigned* st) {
    XcdBarrier b; b.bar = bar; b.x = xb_xcc_id(); b.st = st;
    if (threadIdx.x == 0) (void)xb_add(&bar[XB_XCNT(b.x)], 1u);
    return b;
}
__device__ __forceinline__ void xcd_barrier_complete(unsigned* bar, unsigned x, unsigned& nloc, unsigned& nx) {
    const unsigned G = gridDim.x * gridDim.y * gridDim.z;
    unsigned sum, cnt, mine, sp = 0u;
    for (;;) {
        sum = 0u; cnt = 0u; mine = 0u;
#pragma unroll
        for (unsigned j = 0; j < 16; ++j) { const unsigned c = xb_ld(&bar[XB_XCNT(j)]); sum += c; cnt += (c > 0u) ? 1u : 0u; mine = (j == x) ? c : mine; }
        if (sum == G) break;
        __builtin_amdgcn_s_sleep(1);
        if ((++sp & 255u) == 0u) { if (xb_ld(&bar[XB_TMO])) break; if (sp > XB_SPIN_CAP) { atomicAdd(&bar[XB_TMO], 1u); break; } }
    }
    nloc = mine > 0u ? mine : 1u; nx = cnt > 0u ? cnt : 1u;
}
__device__ __forceinline__ void xcd_barrier(const XcdBarrier& b) {
    asm volatile("s_waitcnt vmcnt(0)" ::: "memory");
    __syncthreads();
    if (threadIdx.x == 0) {
        unsigned* bar = b.bar;
        __builtin_amdgcn_s_waitcnt(0);
        unsigned nloc = b.st[0], nx = b.st[1];
        if (nloc == 0u) { xcd_barrier_complete(bar, b.x, nloc, nx); b.st[0] = nloc; b.st[1] = nx; }
        const unsigned old = xb_add(&bar[XB_XSUB(b.x)], 1u);
        const unsigned gen = old / nloc;
        if (old + 1u == (gen + 1u) * nloc) {
            __builtin_amdgcn_fence(__ATOMIC_RELEASE, "agent");
            asm volatile("s_waitcnt vmcnt(0)" ::: "memory");
            const unsigned og = xb_add(&bar[XB_TOP], 1u);
            const unsigned tg = og / nx;
            if (og + 1u == (tg + 1u) * nx) xb_add(&bar[XB_TOPGEN], 1u);
            else XB_SPIN(xb_ld(&bar[XB_TOPGEN]) == tg, bar);
            __builtin_amdgcn_fence(__ATOMIC_ACQUIRE, "agent");
            xb_add(&bar[XB_XGEN(b.x)], 1u);
            asm volatile("s_waitcnt vmcnt(0)" ::: "memory");
        } else {
            XB_SPIN(xb_ld(&bar[XB_XGEN(b.x)]) == gen, bar);
            __builtin_amdgcn_fence(__ATOMIC_ACQUIRE, "agent");
            asm volatile("s_waitcnt vmcnt(0)" ::: "memory");
        }
    }
    __syncthreads();
}

__device__ __forceinline__ float wave_sum(float v) {
#pragma unroll
    for (int o = 1; o < 64; o <<= 1) v += __shfl_xor(v, o);
    return v;
}

struct TItem { const float* Wc; const float* gain; bf16_t* WT; int ldn, k0, ldk, dest_row0, mode; };
__device__ __forceinline__ void p0_titem_load(const TItem& t, float (&v)[32], int lane) {
    const float* src = t.Wc + (size_t)(t.k0 + (lane >> 5)) * t.ldn + (lane & 31);
#pragma unroll
    for (int i = 0; i < 32; ++i) v[i] = src[(size_t)(2 * i) * t.ldn];
}
__device__ __forceinline__ void p0_titem_store(const TItem& t, float (&v)[32], LAS float* scr, int lane) {
    if (t.gain) {
#pragma unroll
        for (int i = 0; i < 32; ++i) v[i] *= t.gain[t.k0 + 2 * i + (lane >> 5)]; }
#pragma unroll
    for (int i = 0; i < 32; ++i) scr[(2 * i + (lane >> 5)) * 33 + (lane & 31)] = v[i];
    asm volatile("s_waitcnt lgkmcnt(0)" ::: "memory");
    const int c = lane & 7;
#pragma unroll
    for (int j = 0; j < 4; ++j) { const int n = (lane >> 3) + 8 * j; const LAS float* s = scr + (8 * c) * 33 + n;
        u32x4 o; o.x = cvt_pk_bf16(s[0 * 33], s[1 * 33]); o.y = cvt_pk_bf16(s[2 * 33], s[3 * 33]); o.z = cvt_pk_bf16(s[4 * 33], s[5 * 33]); o.w = cvt_pk_bf16(s[6 * 33], s[7 * 33]);
        int drow = t.dest_row0 + n; if (t.mode == 1) { const int oc = drow; drow = (oc & ~255) + 128 * ((oc >> 3) & 1) + 32 * ((oc >> 6) & 3) + 8 * ((oc >> 4) & 3) + (oc & 7); }
        *(u32x4*)(t.WT + (size_t)drow * t.ldk + t.k0 + 8 * c) = o; }
    asm volatile("s_waitcnt lgkmcnt(0)" ::: "memory");
}

struct Args { const float* in[17]; float* out; unsigned char* ws; int ph_lo, ph_hi; };

#ifndef MK_SKIP_MOE
#define MK_SKIP_MOE 0
#endif
constexpr int N_PHASES = 9;

__global__ void __launch_bounds__(NWAVES * 64, 2) hymba_fwd(Args args) {
    extern __shared__ __attribute__((aligned(16))) unsigned char lds_raw[];
    LAS unsigned char* lds = (LAS unsigned char*)lds_raw;
    const int tid = threadIdx.x, lane = tid & 63; const int wave = __builtin_amdgcn_readfirstlane(tid >> 6);
    const int G = gridDim.x; const int bx = blockIdx.x; const int vcu = (G % 8 == 0) ? (bx % 8) * (G / 8) + bx / 8 : bx;
    unsigned char* ws = args.ws;
    unsigned* ctl = (unsigned*)(ws + WS_CTL);
    const float* x = args.in[0]; const float* w_in = args.in[1]; const float* b_forget = args.in[2]; const float* attn_norm = args.in[3];
    const float* on_dil = args.in[4]; const float* on_fox = args.in[5]; const float* w_out = args.in[6]; const float* ffn_norm = args.in[7];
    const float* w_rg = args.in[8]; const float* b_rg = args.in[9]; const float* w_re = args.in[10]; const float* b_re = args.in[11];
    const float* w_gate = args.in[12]; const float* w_up = args.in[13]; const float* w_down = args.in[14]; const float* rel_bias = args.in[15]; const float* final_norm = args.in[16];
    float* rstd1 = (float*)(ws + WS_RSTD1); float* ctot = (float*)(ws + WS_CTOT); float* nrm = (float*)(ws + WS_NRM); bf16_t* WrT = (bf16_t*)(ws + WS_WR);
    float* cl = (float*)(ws + WS_CL); float* lse = (float*)(ws + WS_LSE); float* cf2 = (float*)(ws + WS_CF2);
    bf16_t* WinT = (bf16_t*)(ws + WS_WIN); bf16_t* WoutT = (bf16_t*)(ws + WS_WOUT); bf16_t* WguT = (bf16_t*)(ws + WS_WGU); bf16_t* WdT = (bf16_t*)(ws + WS_WD);
    int* list_tok = (int*)(ws + WS_LTOK); float* list_w = (float*)(ws + WS_LW); float* list_rs = (float*)(ws + WS_LRS); int* tokmap = (int*)(ws + WS_TMAP);
    bf16_t* xb = (bf16_t*)(ws + WS_XB); bf16_t* On = (bf16_t*)(ws + WS_ON);
    bf16_t* qkv = (bf16_t*)(ws + WS_QKV); unsigned char* yslot = (unsigned char*)(ws + WS_QKV);
    bf16_t* og = (bf16_t*)(ws + WS_OG); bf16_t* of = (bf16_t*)(ws + WS_OF); bf16_t* Hb = (bf16_t*)(ws + WS_H); bf16_t* x1b = (bf16_t*)(ws + WS_X1B);

    for (int u = tid; u < (LDS_BYTES - MISC_OFF) / 4; u += NWAVES * 64) ((LAS unsigned*)(lds + MISC_OFF))[u] = 0u;
    __syncthreads();
    const int lo = args.ph_lo, hi_ph = args.ph_hi;
    const bool one_launch = (hi_ph - lo) > 1;
    XcdBarrier bar; bar.bar = ctl + CW_BAR; bar.x = 0; bar.st = nullptr;
    if (one_launch) bar = xcd_barrier_post(ctl + CW_BAR, (volatile LAS unsigned*)(lds + MISC_OFF));
#ifndef PHASE_MASK
#define PHASE_MASK 0x1ff
#endif
#define IN(k) (((PHASE_MASK >> (k)) & 1) && lo <= (k) && (k) < hi_ph)
#define SEAM(k) do { if (IN(k) && IN((k) + 1)) xcd_barrier(bar); } while (0)

    if (IN(0)) {
        {
        LAS float* scr = (LAS float*)(lds + wave * 8704);
        const int gw = vcu * NWAVES + wave, NGW = G * NWAVES;
        constexpr int I_IN = 16 * 96, I_OUT = 16 * 32, I_G = NE * 16 * 8, I_D = NE * 4 * 32;
        constexpr int NIT = I_IN + I_OUT + 2 * I_G + I_D;
#define MK_ITEM(it_, T_) do { int r = (it_); \
            if (r < I_IN) { const int kb = r / 96, nb = r % 96; T_ = TItem{w_in + 32 * nb, attn_norm, WinT, DIN, 64 * kb, D, 32 * nb, 0}; } \
            else if ((r -= I_IN) < I_OUT) { const int kb = r / 32, nb = r % 32; T_ = TItem{w_out + 32 * nb, (kb < 8) ? on_dil : on_fox - DH, WoutT, D, 64 * kb, D, 32 * nb, 0}; } \
            else if ((r -= I_OUT) < 2 * I_G) { const int up = r >= I_G; if (up) r -= I_G; const int e = r / 128, q = r % 128, kb = q / 8, nb = q % 8, n0 = 32 * nb; \
                T_ = TItem{(up ? w_up : w_gate) + (size_t)e * D * DE + n0, ffn_norm, WguT + (size_t)e * 512 * D, DE, 64 * kb, D, (n0 >> 7) * 256 + up * 128 + (n0 & 127), 0}; } \
            else { r -= 2 * I_G; const int e = r / 128, q = r % 128, kb = q / 32, nb = q % 32; \
                T_ = TItem{w_down + (size_t)e * DE * D + 32 * nb, nullptr, WdT + (size_t)e * D * DE, D, 64 * kb, DE, 32 * nb, 1}; } } while (0)
        for (int it = gw; it < NIT; it += 2 * NGW) {
            TItem ta, tb2; float va[32], vb[32];
            MK_ITEM(it, ta); p0_titem_load(ta, va, lane);
            const bool two = (it + NGW < NIT);
            if (two) { MK_ITEM(it + NGW, tb2); p0_titem_load(tb2, vb, lane); }
            p0_titem_store(ta, va, scr, lane);
            if (two) p0_titem_store(tb2, vb, scr, lane);
        }
#undef MK_ITEM
        for (int it = gw * 64 + lane; it < 48 * 128; it += NGW * 64) { const int n = it >> 7, k8 = (it & 127) * 8; float v[8];
#pragma unroll
            for (int q = 0; q < 8; ++q) { const int k = k8 + q; float w = 0.f; if (n < 32) w = w_re[(size_t)k * NE + n]; else if (n < 36) w = w_rg[(size_t)k * NG + (n - 32)]; v[q] = w * ffn_norm[k]; }
            u32x4 o; o.x = cvt_pk_bf16(v[0], v[1]); o.y = cvt_pk_bf16(v[2], v[3]); o.z = cvt_pk_bf16(v[4], v[5]); o.w = cvt_pk_bf16(v[6], v[7]);
            *(u32x4*)(WrT + (size_t)n * D + k8) = o; }
        }
        __syncthreads();
        LAS unsigned short* wfh = (LAS unsigned short*)(lds); LAS unsigned short* wfl = (LAS unsigned short*)(lds + 32768);
        for (int i = tid; i < 4096; i += NWAVES * 64) ((LAS u32x4*)lds)[i] = (u32x4){0u, 0u, 0u, 0u};
        __syncthreads();
        for (int k = tid; k < D; k += NWAVES * 64) { const float gk = attn_norm[k]; const f32x4 a = *(const f32x4*)(w_in + (size_t)k * DIN + NQKV) * gk, b2 = *(const f32x4*)(w_in + (size_t)k * DIN + NQKV + 4) * gk;
            const int ent = ((k >> 5) * 4 + ((k >> 3) & 3)) * 16, j = k & 7;
#pragma unroll
            for (int c = 0; c < 8; ++c) { const float v = c < 4 ? a[c] : b2[c - 4]; const unsigned hw = cvt_pk_bf16(v, 0.f) & 0xffffu; const float hf = __builtin_bit_cast(float, hw << 16);
                const unsigned lw = cvt_pk_bf16(v - hf, 0.f) & 0xffffu; wfh[(ent + c) * 8 + j] = (unsigned short)hw; wfl[(ent + c) * 8 + j] = (unsigned short)lw; } }
        __syncthreads();
        {
        LAS float* lf = (LAS float*)(lds + 65536);
        LAS float* segs = lf + 1024;
        LAS float* rsl = segs + 128 + wave * 16;
        for (int ch = bx; ch < M / 128; ch += G) {
            const int rl = lane & 15, g_ = lane >> 4; const size_t row = (size_t)ch * 128 + wave * 16 + rl;
            const float* xr = x + row * D + 8 * g_; bf16_t* xo = xb + row * D + 8 * g_;
            f32x4 acc = (f32x4){0.f, 0.f, 0.f, 0.f}; float ss = 0.f;
#pragma unroll 8
            for (int kk = 0; kk < 32; ++kk) {
                const f32x4 v0 = *(const f32x4*)(xr + 32 * kk), v1 = *(const f32x4*)(xr + 32 * kk + 4);
                ss += (v0.x * v0.x + v0.y * v0.y) + (v0.z * v0.z + v0.w * v0.w) + (v1.x * v1.x + v1.y * v1.y) + (v1.z * v1.z + v1.w * v1.w);
                u32x4 hw; hw.x = cvt_pk_bf16(v0.x, v0.y); hw.y = cvt_pk_bf16(v0.z, v0.w); hw.z = cvt_pk_bf16(v1.x, v1.y); hw.w = cvt_pk_bf16(v1.z, v1.w);
                *(u32x4*)(xo + 32 * kk) = hw;
                u32x4 lw; lw.x = cvt_pk_bf16(v0.x - bf_lo(hw.x), v0.y - bf_hi(hw.x)); lw.y = cvt_pk_bf16(v0.z - bf_lo(hw.y), v0.w - bf_hi(hw.y));
                lw.z = cvt_pk_bf16(v1.x - bf_lo(hw.z), v1.y - bf_hi(hw.z)); lw.w = cvt_pk_bf16(v1.z - bf_lo(hw.w), v1.w - bf_hi(hw.w));
                const bf16x8 ah = __builtin_bit_cast(bf16x8, hw), al = __builtin_bit_cast(bf16x8, lw);
                const bf16x8 bh = *(const LAS bf16x8*)(lds + (((kk * 4 + g_) * 16 + rl) * 16)), bl = *(const LAS bf16x8*)(lds + 32768 + (((kk * 4 + g_) * 16 + rl) * 16));
                acc = __builtin_amdgcn_mfma_f32_16x16x32_bf16(ah, bh, acc, 0, 0, 0);
                acc = __builtin_amdgcn_mfma_f32_16x16x32_bf16(al, bh, acc, 0, 0, 0);
                acc = __builtin_amdgcn_mfma_f32_16x16x32_bf16(ah, bl, acc, 0, 0, 0);
            }
            ss += __shfl_xor(ss, 16); ss += __shfl_xor(ss, 32);
            const float rs = 1.0f / sqrtf(ss * (1.0f / D) + EPS);
            if (lane < 16) { rsl[lane] = rs; rstd1[row] = rs; }
            asm volatile("s_waitcnt lgkmcnt(0)" ::: "memory");
            if (rl < 8) { const float bfv = b_forget[rl];
#pragma unroll
                for (int i = 0; i < 4; ++i) { const float z = acc[i] * rsl[4 * g_ + i] + bfv; lf[(wave * 16 + 4 * g_ + i) * 8 + rl] = fminf(z, 0.f) - log1pf(expf(-fabsf(z))); } }
            __syncthreads();
            if (tid < 128) { const int hh = tid & 7, sg = tid >> 3; float s = 0.f;
#pragma unroll
                for (int i = 0; i < 8; ++i) { s += lf[(sg * 8 + i) * 8 + hh]; lf[(sg * 8 + i) * 8 + hh] = s; }
                segs[sg * 8 + hh] = s; }
            __syncthreads();
            if (tid < 8) { float s = 0.f;
#pragma unroll
                for (int i = 0; i < 16; ++i) { const float t_ = segs[i * 8 + tid]; segs[i * 8 + tid] = s; s += t_; }
                ctot[(size_t)ch * 8 + tid] = s; }
            __syncthreads();
            for (int i = tid; i < 1024; i += NWAVES * 64) { const int r_ = i >> 3, hh = i & 7; cl[((size_t)ch * 128 + r_) * 8 + hh] = lf[i] + segs[(r_ >> 3) * 8 + hh]; }
            __syncthreads();
        }
        }
    }
    SEAM(0);

    if (IN(1)) {
        { LAS float* part = (LAS float*)(lds);
          for (int ch = bx; ch < M / 128; ch += G) { const int b_ = ch >> 6, jc = ch & 63, j_ = tid >> 3, hh = tid & 7;
            float v = (j_ < jc) ? ctot[((size_t)b_ * 64 + j_) * NH + hh] : 0.f;
            v += __shfl_xor(v, 8); v += __shfl_xor(v, 16); v += __shfl_xor(v, 32);
            if (lane < 8) part[wave * 8 + lane] = v;
            __syncthreads();
            for (int i = tid; i < 1024; i += NWAVES * 64) { const int h2 = i >> 7, r_ = i & 127; float pre = 0.f;
#pragma unroll
                for (int w_ = 0; w_ < 8; ++w_) pre += part[w_ * 8 + h2];
                cf2[((size_t)b_ * NH + h2) * T + jc * 128 + r_] = (cl[((size_t)ch * 128 + r_) * NH + h2] + pre) * LOG2E; }
            __syncthreads(); } }
        pg8::Gemm g{xb, WinT, M, NQKV, D}; pg8::StaticOrder S; S.init(M, NQKV, G, bx);
        epi::EpiQKV E{qkv, rstd1, nrm};
        pg8::gemm_phase<epi::EpiQKV, pg8::StaticOrder, false>(lds, g, S, E);
    }
    SEAM(1);

    if (IN(2)) {
#ifndef ATT_NP
#define ATT_NP 1
#endif
        att::dil_stream(vcu, qkv, og, lse, cf2, rel_bias, (LAS char*)lds);
#pragma unroll 1
        for (int ps = 0; ps < ATT_NP; ++ps) att::attn_phase<0, 1, ATT_NP>(ps, vcu, qkv, og, lse, of, cf2, nrm, rel_bias, (LAS char*)lds);
    }
#ifdef PROBE_EXTRA_PHASE
    if (lo == 13) att::dil_stream(vcu, qkv, og, lse, cf2, rel_bias, (LAS char*)lds);
    if (lo == 14) att::attn_phase<0, 1, 1>(0, vcu, qkv, og, lse, of, cf2, nrm, rel_bias, (LAS char*)lds);
#endif
    SEAM(2);

    if (IN(3)) {
        const int gw = vcu * NWAVES + wave, NGW = G * NWAVES;
        for (int row0 = gw; row0 < M; row0 += 4 * NGW) {
            float od[4][8], ofx[4][8]; float sd[4] = {0.f, 0.f, 0.f, 0.f}, sf[4] = {0.f, 0.f, 0.f, 0.f};
#pragma unroll
            for (int rr = 0; rr < 4; ++rr) { const int row = (row0 + rr * NGW < M) ? row0 + rr * NGW : row0;
                const int hd = lane >> 3;
                float l0 = lse[((size_t)0 * M + row) * NH + hd], l1 = lse[((size_t)1 * M + row) * NH + hd], l2 = lse[((size_t)2 * M + row) * NH + hd];
                const u32x4 a = *(const u32x4*)(og + ((size_t)0 * M + row) * DH + 8 * lane), b2 = *(const u32x4*)(og + ((size_t)1 * M + row) * DH + 8 * lane), c2 = *(const u32x4*)(og + ((size_t)2 * M + row) * DH + 8 * lane);
                const u32x4 f = *(const u32x4*)(of + (size_t)row * DH + 8 * lane);
                const float mx = fmaxf(l0, fmaxf(l1, l2));
                float e0 = __builtin_amdgcn_exp2f(l0 - mx), e1 = __builtin_amdgcn_exp2f(l1 - mx), e2 = __builtin_amdgcn_exp2f(l2 - mx);
                const float inv = 1.0f / (e0 + e1 + e2); e0 *= inv; e1 *= inv; e2 *= inv;
#pragma unroll
                for (int q = 0; q < 4; ++q) {
                    od[rr][2 * q] = e0 * bf_lo(a[q]) + e1 * bf_lo(b2[q]) + e2 * bf_lo(c2[q]); od[rr][2 * q + 1] = e0 * bf_hi(a[q]) + e1 * bf_hi(b2[q]) + e2 * bf_hi(c2[q]);
                    ofx[rr][2 * q] = bf_lo(f[q]); ofx[rr][2 * q + 1] = bf_hi(f[q]);
                    sd[rr] += od[rr][2 * q] * od[rr][2 * q] + od[rr][2 * q + 1] * od[rr][2 * q + 1]; sf[rr] += ofx[rr][2 * q] * ofx[rr][2 * q] + ofx[rr][2 * q + 1] * ofx[rr][2 * q + 1]; } }
#pragma unroll
            for (int o = 1; o < 64; o <<= 1) {
#pragma unroll
                for (int rr = 0; rr < 4; ++rr) { sd[rr] += __shfl_xor(sd[rr], o); sf[rr] += __shfl_xor(sf[rr], o); } }
#pragma unroll
            for (int rr = 0; rr < 4; ++rr) { const int row = (row0 + rr * NGW < M) ? row0 + rr * NGW : row0;
                const float rd = 1.0f / sqrtf(sd[rr] * (1.0f / DH) + EPS), rf = 1.0f / sqrtf(sf[rr] * (1.0f / DH) + EPS);
                u32x4 o1, o2;
#pragma unroll
                for (int q = 0; q < 4; ++q) { o1[q] = cvt_pk_bf16(od[rr][2 * q] * rd, od[rr][2 * q + 1] * rd); o2[q] = cvt_pk_bf16(ofx[rr][2 * q] * rf, ofx[rr][2 * q + 1] * rf); }
                *(u32x4*)(On + (size_t)row * D + 8 * lane) = o1; *(u32x4*)(On + (size_t)row * D + DH + 8 * lane) = o2; }
        }
    }
    SEAM(3);

    if (IN(4)) {
        pg8::Gemm g{On, WoutT, M, D, D}; pg8::StaticOrder S; S.init(M, D, G, bx);
        epi::EpiRes E{xb, x1b};
        pg8::gemm_phase<epi::EpiRes, pg8::StaticOrder, false>(lds, g, S, E);
    }
    SEAM(4);

    if (IN(5) && !MK_SKIP_MOE) {
        for (int it = tid; it < 48 * 128; it += NWAVES * 64) { const int n = it >> 7, c8 = it & 127, kk = c8 >> 2, g_ = c8 & 3, cb = n >> 4, col = n & 15;
            *(LAS u32x4*)(lds + ((((kk * 3 + cb) * 4 + g_) * 16 + col) * 16)) = *(const u32x4*)(WrT + (size_t)n * D + c8 * 8); }
        LAS float* lg = (LAS float*)(lds + 98304 + wave * 3072);
        LAS int* hist = (LAS int*)(lds + 98304 + 8 * 3072);
        LAS int* gbase = hist + 32;
        __syncthreads();
        for (int ch = bx; ch < M / 128; ch += G) {
            if (tid < 32) hist[tid] = 0;
            const int rl = lane & 15, g_ = lane >> 4; const size_t row = (size_t)ch * 128 + wave * 16 + rl;
            const bf16_t* ar = x1b + row * D + 8 * g_;
            f32x4 acc[3]; acc[0] = (f32x4){0.f, 0.f, 0.f, 0.f}; acc[1] = acc[0]; acc[2] = acc[0];
            float ss = 0.f;
#pragma unroll 16
            for (int kk = 0; kk < 32; ++kk) {
                const bf16x8 a = *(const bf16x8*)(ar + 32 * kk);
                const u32x4 au = __builtin_bit_cast(u32x4, a);
#pragma unroll
                for (int q = 0; q < 4; ++q) { const float lo_ = bf_lo(au[q]), hi_ = bf_hi(au[q]); ss += lo_ * lo_ + hi_ * hi_; }
#pragma unroll
                for (int cb = 0; cb < 3; ++cb) { const bf16x8 bfr = *(const LAS bf16x8*)(lds + ((((kk * 3 + cb) * 4 + g_) * 16 + rl) * 16));
                    acc[cb] = __builtin_amdgcn_mfma_f32_16x16x32_bf16(a, bfr, acc[cb], 0, 0, 0); }
            }
            ss += __shfl_xor(ss, 16); ss += __shfl_xor(ss, 32);
            const float rs2 = 1.0f / sqrtf(ss * (1.0f / D) + EPS);
#pragma unroll
            for (int cb = 0; cb < 3; ++cb)
#pragma unroll
                for (int i = 0; i < 4; ++i) lg[(4 * g_ + i) * 48 + 16 * cb + rl] = acc[cb][i];
            __syncthreads();
            int e_a = 0, e_b = 0, pos_a = 0, pos_b = 0; float w_a = 0.f, w_b = 0.f;
            if (lane < 16) {
                const LAS float* lr = lg + lane * 48;
                float gl[4]; int gi = 0;
#pragma unroll
                for (int i = 0; i < 4; ++i) gl[i] = lr[32 + i] * rs2 + b_rg[i];
                float gm = gl[0];
#pragma unroll
                for (int i = 1; i < 4; ++i) if (gl[i] > gm) { gm = gl[i]; gi = i; }
                float gs = 0.f;
#pragma unroll
                for (int i = 0; i < 4; ++i) gs += expf(gl[i] - gm);
                const float g1 = 1.0f / gs;
                float v1 = -3.0e38f, v2 = -3.0e38f; int i1 = 0, i2 = 0;
#pragma unroll
                for (int i = 0; i < 8; ++i) { const float v = lr[gi * 8 + i] * rs2 + b_re[gi * 8 + i];
                    if (v > v1) { v2 = v1; i2 = i1; v1 = v; i1 = i; } else if (v > v2) { v2 = v; i2 = i; } }
                const float ed = expf(v2 - v1), ga = 1.0f / (1.0f + ed), gb = ed * ga;
                e_a = gi * 8 + i1; e_b = gi * 8 + i2; w_a = g1 * ga; w_b = g1 * gb;
                pos_a = __hip_atomic_fetch_add(hist + e_a, 1, __ATOMIC_RELAXED, __HIP_MEMORY_SCOPE_WORKGROUP); pos_b = __hip_atomic_fetch_add(hist + e_b, 1, __ATOMIC_RELAXED, __HIP_MEMORY_SCOPE_WORKGROUP);
            }
            __syncthreads();
            if (tid < 32) { const int c = hist[tid]; gbase[tid] = c ? (int)__hip_atomic_fetch_add(ctl + CW_ECNT + 64 * tid, (unsigned)c, RLX_AGENT) : 0; }
            __syncthreads();
            if (lane < 16) { const int tok = (int)row;
                const size_t ia = (size_t)e_a * CAP + gbase[e_a] + pos_a, ib = (size_t)e_b * CAP + gbase[e_b] + pos_b;
                list_tok[ia] = tok * 2; list_w[ia] = w_a; list_rs[ia] = rs2;
                list_tok[ib] = tok * 2 + 1; list_w[ib] = w_b; list_rs[ib] = rs2;
                tokmap[tok * 2] = (int)ia; tokmap[tok * 2 + 1] = (int)ib; }
            __syncthreads();
        }
    }
    SEAM(5);

#define MOE_PREFIX() do { LAS int* pre_ = (LAS int*)(lds + MISC_OFF + 64); LAS int* cnt_ = (LAS int*)(lds + MISC_OFF + 256); \
        if (tid == 0) { int s_ = 0; for (int e_ = 0; e_ < NE; ++e_) { const int c_ = (int)__hip_atomic_load(ctl + CW_ECNT + 64 * e_, RLX_AGENT); cnt_[e_] = c_; pre_[e_] = s_; s_ += (c_ + 255) >> 8; } pre_[NE] = s_; } \
        __syncthreads(); } while (0)

    if (IN(6) && !MK_SKIP_MOE) {
        MOE_PREFIX();
        const LAS int* pre = (const LAS int*)(lds + MISC_OFF + 64); const LAS int* cnt = (const LAS int*)(lds + MISC_OFF + 256);
        pg8::Gemm g{x1b, WguT, M, 512, D}; pg8::MoeOrder<1> S{pre, cnt, list_tok, G, vcu};
        epi::EpiGU E{Hb, list_rs, cnt};
        pg8::gemm_phase<epi::EpiGU, pg8::MoeOrder<1>, true>(lds, g, S, E);
    }
    SEAM(6);

    if (IN(7) && !MK_SKIP_MOE) {
        MOE_PREFIX();
        const LAS int* pre = (const LAS int*)(lds + MISC_OFF + 64); const LAS int* cnt = (const LAS int*)(lds + MISC_OFF + 256);
        pg8::Gemm g{Hb, WdT, M, D, DE}; pg8::MoeOrder<2> S{pre, cnt, list_tok, G, vcu};
        epi::EpiDown E{yslot, list_w, cnt};
        pg8::gemm_phase<epi::EpiDown, pg8::MoeOrder<2>, false>(lds, g, S, E);
    }
    SEAM(7);

    if (IN(8)) {
#if !MK_SKIP_MOE
        MOE_PREFIX();
        const LAS int* pre8 = (const LAS int*)(lds + MISC_OFF + 64);
#endif
        const int gw = vcu * NWAVES + wave, NGW = G * NWAVES;
        int tmv = 0;
#if !MK_SKIP_MOE
        { const int rk = gw + (lane >> 1) * NGW; if (lane < 32 && rk < M) tmv = tokmap[rk * 2 + (lane & 1)]; }
#endif
        int kbase = 0;
        for (int row0 = gw; row0 < M; row0 += 4 * NGW, kbase += 4) {
            float v[4][16]; float ss[4] = {0.f, 0.f, 0.f, 0.f};
#pragma unroll
            for (int rr = 0; rr < 4; ++rr) { const int row = (row0 + rr * NGW < M) ? row0 + rr * NGW : row0;
#if !MK_SKIP_MOE
              const int kk_ = (row0 + rr * NGW < M) ? kbase + rr : kbase;
              const int m0 = (kk_ < 16) ? __shfl(tmv, 2 * kk_) : __builtin_amdgcn_readfirstlane(tokmap[row * 2]), m1 = (kk_ < 16) ? __shfl(tmv, 2 * kk_ + 1) : __builtin_amdgcn_readfirstlane(tokmap[row * 2 + 1]);
              const size_t yr0 = (size_t)(pre8[m0 >> 15] * 256 + (m0 & (CAP - 1))), yr1 = (size_t)(pre8[m1 >> 15] * 256 + (m1 & (CAP - 1)));
#endif
#pragma unroll
              for (int hf = 0; hf < 2; ++hf) {
                const size_t co = (size_t)hf * DH + 8 * lane;
                const u32x4 a = *(const u32x4*)(x1b + (size_t)row * D + co);
#if MK_SKIP_MOE
                const u32x2 y0 = (u32x2){0u, 0u}, y1 = y0;
#else
                const u32x2 y0 = *(const u32x2*)(yslot + yr0 * D + co), y1 = *(const u32x2*)(yslot + yr1 * D + co);
#endif
#pragma unroll
                for (int q = 0; q < 4; ++q) { const f32x2 e0 = (q & 1) ? __builtin_amdgcn_cvt_pk_f32_fp8((int)y0[q >> 1], true) : __builtin_amdgcn_cvt_pk_f32_fp8((int)y0[q >> 1], false);
                    const f32x2 e1 = (q & 1) ? __builtin_amdgcn_cvt_pk_f32_fp8((int)y1[q >> 1], true) : __builtin_amdgcn_cvt_pk_f32_fp8((int)y1[q >> 1], false);
                    const float lo_ = bf_lo(a[q]) + (e0.x + e1.x) * 0.0625f, hi_ = bf_hi(a[q]) + (e0.y + e1.y) * 0.0625f;
                    v[rr][hf * 8 + 2 * q] = lo_; v[rr][hf * 8 + 2 * q + 1] = hi_; ss[rr] += lo_ * lo_ + hi_ * hi_; }
              } }
#pragma unroll
            for (int o = 1; o < 64; o <<= 1) { ss[0] += __shfl_xor(ss[0], o); ss[1] += __shfl_xor(ss[1], o); ss[2] += __shfl_xor(ss[2], o); ss[3] += __shfl_xor(ss[3], o); }
#pragma unroll
            for (int rr = 0; rr < 4; ++rr) { const int row = (row0 + rr * NGW < M) ? row0 + rr * NGW : row0;
              const float rs = 1.0f / sqrtf(ss[rr] * (1.0f / D) + EPS);
#pragma unroll
              for (int hf = 0; hf < 2; ++hf) { const size_t co = (size_t)hf * DH + 8 * lane;
                const f32x4 g0 = *(const f32x4*)(final_norm + co), g1 = *(const f32x4*)(final_norm + co + 4);
                f32x4 o0, o1;
#pragma unroll
                for (int q = 0; q < 4; ++q) { o0[q] = v[rr][hf * 8 + q] * rs * g0[q]; o1[q] = v[rr][hf * 8 + 4 + q] * rs * g1[q]; }
                *(f32x4*)(args.out + (size_t)row * D + co) = o0; *(f32x4*)(args.out + (size_t)row * D + co + 4) = o1; } }
        }
    }
#undef IN
#undef SEAM
}

#ifndef MK_N_LAUNCHES
#define MK_N_LAUNCHES 1
#endif
extern "C" void kernel_launch(void* const* d_in, const int* in_sizes, int n_in, void* d_out, int out_size, void* d_ws, size_t ws_size, hipStream_t stream) {
    static int grid = 0;
    if (grid == 0) {
        if (n_in != 17 || in_sizes[0] != M * D || out_size != M * D || ws_size < WS_END) { fprintf(stderr, "kernel_launch: unexpected shapes (n_in %d in0 %d out %d ws %zu)\n", n_in, n_in > 0 ? in_sizes[0] : -1, out_size, ws_size); grid = -1; return; }
        int dev = 0, cus = 0, per_cu = 0;
        if (hipGetDevice(&dev) != hipSuccess || hipDeviceGetAttribute(&cus, hipDeviceAttributeMultiprocessorCount, dev) != hipSuccess) { grid = -1; return; }
        if (hipFuncSetAttribute((const void*)hymba_fwd, hipFuncAttributeMaxDynamicSharedMemorySize, LDS_BYTES) != hipSuccess) { fprintf(stderr, "kernel_launch: hipFuncSetAttribute failed\n"); grid = -1; return; }
        if (hipOccupancyMaxActiveBlocksPerMultiprocessor(&per_cu, (const void*)hymba_fwd, NWAVES * 64, LDS_BYTES) != hipSuccess || per_cu < 1) { fprintf(stderr, "kernel_launch: occupancy query says %d\n", per_cu); }
        (void)hipGetLastError();
        if (cus < 256) { fprintf(stderr, "kernel_launch: this kernel is built for the 256 CUs of MI355X (device reports %d)\n", cus); grid = -1; return; }
        grid = 256;
    }
    if (grid < 0) return;
    (void)hipMemsetAsync((char*)d_ws + WS_CTL, 0, CTL_ZERO_BYTES, stream);
    Args a{};
    for (int i = 0; i < 17; ++i) a.in[i] = (const float*)d_in[i];
    a.out = (float*)d_out; a.ws = (unsigned char*)d_ws;
#if MK_N_LAUNCHES == 1
    a.ph_lo = 0; a.ph_hi = N_PHASES;
    hipLaunchKernelGGL(hymba_fwd, dim3(grid), dim3(NWAVES * 64), LDS_BYTES, stream, a);
#ifdef PROBE_EXTRA_PHASE
    a.ph_lo = PROBE_EXTRA_PHASE; a.ph_hi = PROBE_EXTRA_PHASE + 1;
    hipLaunchKernelGGL(hymba_fwd, dim3(grid), dim3(NWAVES * 64), LDS_BYTES, stream, a);
#endif
#else
    for (int p = 0; p < N_PHASES; ++p) { a.ph_lo = p; a.ph_hi = p + 1; hipLaunchKernelGGL(hymba_fwd, dim3(grid), dim3(NWAVES * 64), LDS_BYTES, stream, a); }
#endif
}
```

```cpp
#include <hip/hip_runtime.h>
#include <hip/hip_bf16.h>
#include <cstdio>
#include <cstdint>

#define GAS __attribute__((address_space(1)))
#define LAS __attribute__((address_space(3)))
typedef unsigned short bf16_t;
typedef short bf16x8 __attribute__((ext_vector_type(8)));
typedef short s16x4 __attribute__((ext_vector_type(4)));
typedef float f32x4 __attribute__((ext_vector_type(4)));
typedef float f32x2 __attribute__((ext_vector_type(2)));
typedef float f32x16 __attribute__((ext_vector_type(16)));
typedef unsigned u32x4 __attribute__((ext_vector_type(4)));
typedef unsigned u32x2 __attribute__((ext_vector_type(2)));
typedef __bf16 bf16x2_t __attribute__((ext_vector_type(2)));

constexpr int BATCH = 4, T = 8192, D = 1024, M = BATCH * T;
constexpr int NH = 8, HD = 64, DH = NH * HD;
constexpr int NQKV = 6 * DH;
constexpr int DIN = NQKV + NH;
constexpr int NE = 32, DE = 256, EPG = 8, NG = 4;
constexpr int CAP = M;
constexpr float EPS = 1e-6f;
constexpr float LOG2E = 1.4426950408889634f;
constexpr float C2 = 0.125f * LOG2E;
constexpr float NEGBIG = -1e30f;

__device__ __forceinline__ unsigned cvt_pk_bf16(float lo, float hi) { f32x2 v = {lo, hi}; bf16x2_t b = __builtin_convertvector(v, bf16x2_t); return __builtin_bit_cast(unsigned, b); }
__device__ __forceinline__ float bf_lo(unsigned w) { return __builtin_bit_cast(float, w << 16); }
__device__ __forceinline__ float bf_hi(unsigned w) { return __builtin_bit_cast(float, w & 0xffff0000u); }

namespace pg8 {
#define PG8_LAS __attribute__((address_space(3)))
constexpr int BM = 256, BK = 64, HALF = 128, HTB = HALF * BK * 2  , STAGE_BYTES = 8 * HTB, NXCD = 8, WGM = 8;

__host__ __device__ __forceinline__ int lds_byte(int r, int c) { const int st = (r >> 4) * 2 + (c >> 5), rr = r & 15, cc = c & 31, ob = rr * 64 + cc * 2; return st * 1024 + (ob ^ (((ob >> 9) & 1) << 5)); }
__host__ __device__ __forceinline__ void stage_rc(int b, int& R, int& C) { const int st = b / 1024, sb = b % 1024, swz = sb ^ (((sb >> 9) & 1) << 5); R = (st >> 1) * 16 + swz / 64; C = (st & 1) * 32 + (swz % 64) / 2; }
__host__ __device__ __forceinline__ int perm32(int rho) { const int n = rho >> 4, i = rho & 15; return 8 * (i >> 2) + 4 * n + (i & 3); }

struct Unit { int pm, pn, e, ti; };
struct Gemm { const bf16_t* A; const bf16_t* Bt; int M, N, K; };

struct StaticOrder {
    int nM, nN, nwg, G, c;
    __host__ __device__ void init(int M_, int N_, int G_, int c_) { nM = M_ / BM; nN = N_ / BM; nwg = nM * nN; G = G_; c = c_; }
    __host__ __device__ bool next(int i, Unit& u) const {
        const long L = (long)i * G + c; if (L >= nwg) return false;
        int wgid = (int)L; { const int q = nwg / NXCD, r = nwg % NXCD, xcd = wgid % NXCD, off = wgid / NXCD; wgid = (xcd < r ? xcd * (q + 1) : r * (q + 1) + (xcd - r) * q) + off; }
        const int nig = WGM * nN, gid = wgid / nig, fm = gid * WGM, gsz = (nM - fm) < WGM ? (nM - fm) : WGM;
        u.pm = fm + ((wgid % nig) % gsz); u.pn = (wgid % nig) / gsz; u.e = 0; u.ti = 0; return true;
    }
    __device__ __forceinline__ int row_token(const Unit&, int) const { return 0; }
};

template <int SH> struct MoeOrder {
    static constexpr int npn = 1 << SH;
    const PG8_LAS int* pre; const PG8_LAS int* cnt; const int* list_tok; int G, c;
    __device__ __forceinline__ bool next(int i, Unit& u) const {
        const int L = i * G + c, total = __builtin_amdgcn_readfirstlane(pre[32]);
        if (L >= total * npn) return false;
        const int tf = L >> SH, pn = L & (npn - 1);
        int e = 0;
#pragma unroll 1
        for (int k = 16; k >= 1; k >>= 1) { const int pv = __builtin_amdgcn_readfirstlane(pre[e + k]); if (pv <= tf) e += k; }
        const int pe = __builtin_amdgcn_readfirstlane(pre[e]);
        u.e = e; u.ti = tf - pe; u.pm = tf; u.pn = e * npn + pn; return true;
    }
    __device__ __forceinline__ int row_token(const Unit& u, int r) const { int idx = u.ti * 256 + r; idx = idx < cnt[u.e] ? idx : 0; return list_tok[(size_t)u.e * CAP + idx] >> 1; }
};

template <class Epi, class Sched, bool GATHER, bool ALIGN_EPI = true>
__device__ __forceinline__ void gemm_phase(PG8_LAS unsigned char* lds, const Gemm g, const Sched& S, const Epi& E) {
    const int tid = threadIdx.x, wid = __builtin_amdgcn_readfirstlane(tid >> 6), lane = tid & 63, wr = wid >> 2, wc = wid & 3, fr = lane & 15, fq = lane >> 4;
    const int K = g.K, nt = K / BK;
    unsigned voffA[2], voffB[2]; int RA[2], CA[2];
#pragma unroll
    for (int i = 0; i < 2; ++i) { int R, C; stage_rc(tid * 16 + i * 8192, R, C); const int Rb = Epi::PERM ? ((R & ~31) + perm32(R & 31)) : R;
        voffA[i] = (unsigned)(R * K + C) * 2u; voffB[i] = (unsigned)(Rb * K + C) * 2u; RA[i] = R; CA[i] = C; }
    const size_t kstep = (size_t)(BK * 2);
    const size_t hstep = (size_t)HALF * K * 2;
    const size_t tstep = 2 * hstep;
    const unsigned ldsw = (unsigned)wid * 1024u;
    const int aoff = lds_byte(wr * 64 + fr, fq * 8), boff = lds_byte(wc * 32 + fr, fq * 8);
#define PG8_SA(b, h) (((b) * 2 + (h)) * HTB)
#define PG8_SB(b, h) ((4 + (b) * 2 + (h)) * HTB)
#define PG8_STAGE(bufoff, gbase, voff) do { _Pragma("unroll") for (int _i = 0; _i < 2; ++_i) \
        __builtin_amdgcn_global_load_lds((const unsigned*)((const char*)(gbase) + (voff)[_i]), (PG8_LAS unsigned*)(lds + (bufoff) + ldsw + _i * 8192), 16, 0, 0); } while (0)
#define PG8_STAGE_A(bufoff, ap, h, offs) do { if constexpr (GATHER) { PG8_STAGE(bufoff, ap, offs[h]); } else { PG8_STAGE(bufoff, (ap) + (h) * hstep, voffA); } } while (0)
#define PG8_LDA(dst, b, h) do { _Pragma("unroll") for (int m = 0; m < 4; ++m) _Pragma("unroll") for (int k = 0; k < 2; ++k) dst[m][k] = *(const PG8_LAS bf16x8*)(lds + PG8_SA(b, h) + aoff + m * 2048 + k * 1024); } while (0)
#define PG8_LDB(dst, b, h) do { _Pragma("unroll") for (int n = 0; n < 2; ++n) _Pragma("unroll") for (int k = 0; k < 2; ++k) dst[n][k] = *(const PG8_LAS bf16x8*)(lds + PG8_SB(b, h) + boff + n * 2048 + k * 1024); } while (0)
#define PG8_MMA(ai, bj, At, Bt) do { __builtin_amdgcn_s_setprio(1); _Pragma("unroll") for (int m = 0; m < 4; ++m) _Pragma("unroll") for (int n = 0; n < 2; ++n) _Pragma("unroll") for (int k = 0; k < 2; ++k) \
        acc[ai][bj][m][n] = __builtin_amdgcn_mfma_f32_16x16x32_bf16(Bt[n][k], At[m][k], acc[ai][bj][m][n], 0, 0, 0); __builtin_amdgcn_s_setprio(0); } while (0)
#define PG8_WAIT_V(n) asm volatile("s_waitcnt vmcnt(" #n ")" ::: "memory")
#define PG8_WAIT_L(n) asm volatile("s_waitcnt lgkmcnt(" #n ")" ::: "memory")
#define PG8_BAR __builtin_amdgcn_s_barrier()
#define PG8_SCHED __builtin_amdgcn_sched_barrier(0)
#define PG8_GOFFS(u_, v_) do { if constexpr (GATHER) { _Pragma("unroll") for (int h_ = 0; h_ < 2; ++h_) _Pragma("unroll") for (int i_ = 0; i_ < 2; ++i_) \
        v_[h_][i_] = (unsigned)(S.row_token(u_, h_ * HALF + RA[i_]) * K + CA[i_]) * 2u; } } while (0)
    Unit cur, nxt; int ui = 0;
    if (!S.next(0, cur)) return;
    f32x4 acc[2][2][4][2];
#pragma unroll
    for (int a = 0; a < 2; ++a)
#pragma unroll
        for (int b = 0; b < 2; ++b)
#pragma unroll
            for (int m = 0; m < 4; ++m)
#pragma unroll
                for (int n = 0; n < 2; ++n) acc[a][b][m][n] = (f32x4){0.f, 0.f, 0.f, 0.f};
    bf16x8 At[4][2], B0[2][2], B1[2][2];
    unsigned vA[2][2] = {{0u, 0u}, {0u, 0u}}, nvA[2][2] = {{0u, 0u}, {0u, 0u}};
    PG8_GOFFS(cur, vA);
    const char* cA = GATHER ? (const char*)g.A : (const char*)g.A + (size_t)cur.pm * tstep; const char* cB = (const char*)g.Bt + (size_t)cur.pn * tstep;
    PG8_STAGE(PG8_SB(0, 0), cB, voffB); PG8_STAGE(PG8_SB(0, 1), cB + hstep, voffB); PG8_STAGE_A(PG8_SA(0, 0), cA, 0, vA); PG8_STAGE_A(PG8_SA(0, 1), cA, 1, vA);
    if (wr == 1) PG8_BAR;
    PG8_WAIT_V(2); PG8_BAR;
    PG8_STAGE(PG8_SB(1, 0), cB + kstep, voffB); PG8_STAGE_A(PG8_SA(1, 0), cA + kstep, 0, vA); PG8_STAGE(PG8_SB(1, 1), cB + hstep + kstep, voffB);
    PG8_WAIT_V(6); PG8_BAR;
    for (;;) {
        const bool has_next = S.next(ui + 1, nxt);
        if (has_next) { PG8_GOFFS(nxt, nvA); } else { if constexpr (GATHER) {
#pragma unroll
            for (int h_ = 0; h_ < 2; ++h_)
#pragma unroll
                for (int i_ = 0; i_ < 2; ++i_) nvA[h_][i_] = vA[h_][i_]; } }
        const char* nA = GATHER ? cA : (has_next ? (const char*)g.A + (size_t)nxt.pm * tstep : cA); const char* nB = has_next ? (const char*)g.Bt + (size_t)nxt.pn * tstep : cB;
#pragma unroll 1
        for (int t = 0; t < nt; t += 2) {
            const bool last = (t == nt - 2);
            const char* a1 = cA + (size_t)(t + 1) * kstep;
            const char* a2 = last ? nA : cA + (size_t)(t + 2) * kstep; const char* b2 = last ? nB : cB + (size_t)(t + 2) * kstep;
            const char* a3 = a2 + kstep; const char* b3 = b2 + kstep;
            unsigned sA[2][2];
#pragma unroll
            for (int h_ = 0; h_ < 2; ++h_)
#pragma unroll
                for (int i_ = 0; i_ < 2; ++i_) sA[h_][i_] = last ? nvA[h_][i_] : vA[h_][i_];
            PG8_LDB(B0, 0, 0); PG8_LDB(B1, 0, 1); PG8_SCHED; PG8_LDA(At, 0, 0); PG8_STAGE_A(PG8_SA(1, 1), a1, 1, vA);
            PG8_WAIT_V(8); PG8_WAIT_L(0); PG8_BAR; PG8_MMA(0, 0, At, B0); PG8_MMA(0, 1, At, B1); PG8_BAR; PG8_SCHED;
            PG8_LDA(At, 0, 1); PG8_STAGE(PG8_SB(0, 0), b2, voffB); PG8_STAGE(PG8_SB(0, 1), b2 + hstep, voffB); PG8_STAGE_A(PG8_SA(0, 0), a2, 0, sA);
            PG8_WAIT_V(8); PG8_WAIT_L(0); PG8_BAR; PG8_MMA(1, 0, At, B0); PG8_MMA(1, 1, At, B1); PG8_BAR; PG8_SCHED;
            PG8_LDB(B0, 1, 0); PG8_LDB(B1, 1, 1); PG8_SCHED; PG8_LDA(At, 1, 0); PG8_STAGE_A(PG8_SA(0, 1), a2, 1, sA);
            PG8_WAIT_V(8); PG8_WAIT_L(0); PG8_BAR; PG8_MMA(0, 0, At, B0); PG8_MMA(0, 1, At, B1); PG8_BAR; PG8_SCHED;
            PG8_LDA(At, 1, 1); PG8_STAGE(PG8_SB(1, 0), b3, voffB); PG8_STAGE(PG8_SB(1, 1), b3 + hstep, voffB); PG8_STAGE_A(PG8_SA(1, 0), a3, 0, sA);
            PG8_WAIT_V(8); PG8_WAIT_L(0); PG8_BAR; PG8_MMA(1, 0, At, B0); PG8_MMA(1, 1, At, B1); PG8_BAR; PG8_SCHED;
        }
        if constexpr (ALIGN_EPI) { if (wr == 0) PG8_BAR; }
        E(acc, cur, wr, wc, fr, fq);
        if (!has_next) break;
#pragma unroll
        for (int a = 0; a < 2; ++a)
#pragma unroll
            for (int b = 0; b < 2; ++b)
#pragma unroll
                for (int m = 0; m < 4; ++m)
#pragma unroll
                    for (int n = 0; n < 2; ++n) acc[a][b][m][n] = (f32x4){0.f, 0.f, 0.f, 0.f};
        cur = nxt; cA = nA; cB = nB; ++ui;
#pragma unroll
        for (int h_ = 0; h_ < 2; ++h_)
#pragma unroll
            for (int i_ = 0; i_ < 2; ++i_) vA[h_][i_] = nvA[h_][i_];
        if constexpr (ALIGN_EPI) { if (wr == 1) PG8_BAR; }
    }
    PG8_WAIT_V(0);
    if constexpr (!ALIGN_EPI) { if (wr == 0) PG8_BAR; }
    PG8_BAR;
#undef PG8_SA
#undef PG8_SB
#undef PG8_STAGE
#undef PG8_STAGE_A
#undef PG8_LDA
#undef PG8_LDB
#undef PG8_MMA
#undef PG8_WAIT_V
#undef PG8_WAIT_L
#undef PG8_BAR
#undef PG8_SCHED
#undef PG8_GOFFS
}
}
namespace epi {
using pg8::Unit;
__device__ __forceinline__ u32x4 pack8(f32x4 v0, f32x4 v1) { u32x4 w; w.x = cvt_pk_bf16(v0[0], v0[1]); w.y = cvt_pk_bf16(v0[2], v0[3]); w.z = cvt_pk_bf16(v1[0], v1[1]); w.w = cvt_pk_bf16(v1[2], v1[3]); return w; }

struct EpiQKV {
    static constexpr bool PERM = true;
    bf16_t* O; const float* rstd; float* nrm;
    __device__ __forceinline__ void operator()(const f32x4 (&acc)[2][2][4][2], const Unit& u, int wr, int wc, int fr, int fq) const {
        const int t = u.pn >> 1, cin = (u.pn & 1) * 256 + wc * 32 + 8 * fq;
        bf16_t* base = O + (size_t)t * ((size_t)M * DH);
        const float sc = (t == 0 || t == 3) ? C2 : 1.f;
        const bool do_n = (t == 3 || t == 4), dil = (t < 3);
        const int row0 = u.pm * 256 + wr * 64 + fr;
        float mx[2][2] = {{0.f, 0.f}, {0.f, 0.f}};
#pragma unroll
        for (int ai = 0; ai < 2; ++ai)
#pragma unroll
            for (int m = 0; m < 4; ++m) { const int r = row0 + ai * 128 + m * 16; const float rs = rstd[r] * sc;
                const int b_ = r >> 13, tt = r & (T - 1);
#pragma unroll
                for (int bj = 0; bj < 2; ++bj) { const f32x4 v0 = acc[ai][bj][m][0] * rs, v1 = acc[ai][bj][m][1] * rs;
                    const int c0 = cin + bj * 128, hd_ = c0 >> 6, dd = c0 & 63, bh_ = b_ * NH + hd_;
                    const size_t orow = dil ? ((size_t)(bh_ * 16 + (tt & 15)) * 512 + (tt >> 4)) : ((size_t)bh_ * T + tt);
                    *(u32x4*)(base + orow * HD + dd) = pack8(v0, v1);
                    if (do_n) { float s = (v0[0] * v0[0] + v0[1] * v0[1]) + (v0[2] * v0[2] + v0[3] * v0[3]) + (v1[0] * v1[0] + v1[1] * v1[1]) + (v1[2] * v1[2] + v1[3] * v1[3]);
                        s += __shfl_xor(s, 16); s += __shfl_xor(s, 32); mx[ai][bj] = fmaxf(mx[ai][bj], s); } } }
        if (do_n) {
#pragma unroll
            for (int ai = 0; ai < 2; ++ai)
#pragma unroll
                for (int bj = 0; bj < 2; ++bj) { float v = mx[ai][bj];
                    v = fmaxf(v, __shfl_xor(v, 1)); v = fmaxf(v, __shfl_xor(v, 2)); v = fmaxf(v, __shfl_xor(v, 4)); v = fmaxf(v, __shfl_xor(v, 8));
                    const int tile64 = u.pm * 4 + ai * 2 + wr, head = (u.pn & 1) * 4 + 2 * bj + (wc >> 1);
                    if ((threadIdx.x & 63) == 0) nrm[(((size_t)(t - 3) * (M / 64) + tile64) * NH + head) * 2 + (wc & 1)] = v; }
        }
    }
};

struct EpiRes {
    static constexpr bool PERM = true;
    const bf16_t* xb; bf16_t* x1b;
    __device__ __forceinline__ void operator()(const f32x4 (&acc)[2][2][4][2], const Unit& u, int wr, int wc, int fr, int fq) const {
        const int row0 = u.pm * 256 + wr * 64 + fr, col0 = u.pn * 256 + wc * 32 + 8 * fq;
#pragma unroll
        for (int ai = 0; ai < 2; ++ai)
#pragma unroll
            for (int m = 0; m < 4; ++m) { const size_t off = (size_t)(row0 + ai * 128 + m * 16) * D + col0;
#pragma unroll
                for (int bj = 0; bj < 2; ++bj) { const u32x4 xv = *(const u32x4*)(xb + off + bj * 128);
                    const f32x4 x0 = (f32x4){bf_lo(xv.x), bf_hi(xv.x), bf_lo(xv.y), bf_hi(xv.y)}, x1 = (f32x4){bf_lo(xv.z), bf_hi(xv.z), bf_lo(xv.w), bf_hi(xv.w)};
                    *(u32x4*)(x1b + off + bj * 128) = pack8(acc[ai][bj][m][0] + x0, acc[ai][bj][m][1] + x1); } if (m & 1) asm volatile("" ::: "memory"); }
    }
};

struct EpiGU {
    static constexpr bool PERM = true;
    bf16_t* H; const float* list_rs; const LAS int* cnt;
    __device__ __forceinline__ void operator()(const f32x4 (&acc)[2][2][4][2], const Unit& u, int wr, int wc, int fr, int fq) const {
        const int pn = u.pn & 1, col0 = pn * 128 + wc * 32 + 8 * fq, r0 = wr * 64 + fr, ne = cnt[u.e];
        float rsv[2][4];
#pragma unroll
        for (int ai = 0; ai < 2; ++ai)
#pragma unroll
            for (int m = 0; m < 4; ++m) { int idx = u.ti * 256 + r0 + ai * 128 + m * 16; idx = idx < ne ? idx : 0; rsv[ai][m] = list_rs[(size_t)u.e * CAP + idx]; }
#pragma unroll
        for (int ai = 0; ai < 2; ++ai)
#pragma unroll
            for (int m = 0; m < 4; ++m) { const int r = r0 + ai * 128 + m * 16; const float rs = rsv[ai][m];
                f32x4 hv[2];
#pragma unroll
                for (int n = 0; n < 2; ++n) { const f32x4 gt = acc[ai][0][m][n] * rs, up = acc[ai][1][m][n] * rs;
#pragma unroll
                    for (int q = 0; q < 4; ++q) { const float sg = gt[q] * __builtin_amdgcn_rcpf(1.f + __builtin_amdgcn_exp2f(-gt[q] * LOG2E)); hv[n][q] = sg * up[q]; } }
                *(u32x4*)(H + ((size_t)u.pm * 256 + r) * DE + col0) = pack8(hv[0], hv[1]); }
    }
};

struct EpiDown {
    static constexpr bool PERM = true;
    unsigned char* Y; const float* list_w; const LAS int* cnt;
    __device__ __forceinline__ void operator()(const f32x4 (&acc)[2][2][4][2], const Unit& u, int wr, int wc, int fr, int fq) const {
        const int pn = u.pn & 3, col0 = pn * 256 + wc * 64 + 16 * fq, r0 = wr * 64 + fr, ne = cnt[u.e];
        float wv[2][4];
#pragma unroll
        for (int ai = 0; ai < 2; ++ai)
#pragma unroll
            for (int m = 0; m < 4; ++m) { const int idx = u.ti * 256 + r0 + ai * 128 + m * 16; const int ic = idx < ne ? idx : 0; wv[ai][m] = list_w[(size_t)u.e * CAP + ic] * 16.0f; }
#pragma unroll
        for (int ai = 0; ai < 2; ++ai)
#pragma unroll
            for (int m = 0; m < 4; ++m) { const float w = wv[ai][m]; u32x4 o;
#pragma unroll
                for (int bj = 0; bj < 2; ++bj)
#pragma unroll
                    for (int n = 0; n < 2; ++n) { const f32x4 v = acc[ai][bj][m][n] * w; int pk = 0;
                        pk = __builtin_amdgcn_cvt_pk_fp8_f32(v[0], v[1], pk, false); pk = __builtin_amdgcn_cvt_pk_fp8_f32(v[2], v[3], pk, true); o[bj * 2 + n] = (unsigned)pk; }
                *(u32x4*)(Y + ((size_t)u.pm * 256 + r0 + ai * 128 + m * 16) * D + col0) = o; }
    }
};
}
namespace att {
constexpr int PITCH = DH;
constexpr int NSLOT = 6, SLOTB = 8192, PF = 5;
constexpr int L_K = 0, L_V = NSLOT * SLOTB, L_TAB = 2 * NSLOT * SLOTB;
constexpr int TABN = 336;
constexpr int L_CK = L_TAB + 8192;
constexpr int L_MISC = L_CK + 32768;
constexpr int L_END = L_MISC + 1024;
typedef LAS const char* lds_cptr;
typedef short v4i16_t __attribute__((ext_vector_type(4)));

__device__ const unsigned char BUCKET[3][132] = {
 {0,1,2,3,4,5,6,7,8,9,10,11,12,13,14,15,16,16,16,16,16,16,17,17,17,17,17,17,17,17,18,18,18,18,18,18,18,18,18,18,19,19,19,19,19,19,19,19,19,19,19,19,19,19,20,20,20,20,20,20,20,20,20,20,20,20,20,20,20,20,20,20,20,21,21,21,21,21,21,21,21,21,21,21,21,21,21,21,21,21,21,21,21,21,21,21,21,21,21,22,22,22,22,22,22,22,22,22,22,22,22,22,22,22,22,22,22,22,22,22,22,22,22,22,22,22,22,22,22,0,0,0},
 {0,4,8,12,16,16,17,17,18,18,19,19,19,19,20,20,20,20,20,21,21,21,21,21,21,22,22,22,22,22,22,22,22,22,23,23,23,23,23,23,23,23,23,23,23,23,24,24,24,24,24,24,24,24,24,24,24,24,24,24,24,24,25,25,25,25,25,25,25,25,25,25,25,25,25,25,25,25,25,25,25,25,25,26,26,26,26,26,26,26,26,26,26,26,26,26,26,26,26,26,26,26,26,26,26,26,26,26,26,26,26,26,26,27,27,27,27,27,27,27,27,27,27,27,27,27,27,27,27,0,0,0},
 {0,16,18,19,20,21,21,22,22,23,23,23,24,24,24,24,25,25,25,25,25,26,26,26,26,26,26,26,26,27,27,27,27,27,27,27,27,27,27,28,28,28,28,28,28,28,28,28,28,28,28,28,29,29,29,29,29,29,29,29,29,29,29,29,29,29,29,29,29,29,30,30,30,30,30,30,30,30,30,30,30,30,30,30,30,30,30,30,30,30,30,30,30,30,30,31,31,31,31,31,31,31,31,31,31,31,31,31,31,31,31,31,31,31,31,31,31,31,31,31,31,31,31,31,31,31,31,31,31,0,0,0}};

__device__ __forceinline__ int crow(int r, int hi) { return (r & 3) + 8 * (r >> 2) + 4 * hi; }
__device__ __forceinline__ s16x4 vtr(lds_cptr p) { return __builtin_bit_cast(s16x4, __builtin_amdgcn_ds_read_tr16_b64_v4i16((LAS v4i16_t*)p)); }
__device__ __forceinline__ void glds16(const void* gsrc, unsigned lds_dst) { unsigned keep;
    asm volatile("s_mov_b32 %0, m0\n\ts_mov_b32 m0, %2\n\ts_nop 0\n\tglobal_load_lds_dwordx4 %1, off\n\ts_mov_b32 m0, %0" : "=&s"(keep) : "v"(gsrc), "s"(lds_dst) : "memory"); }
__device__ __forceinline__ void glds4(const void* gsrc, unsigned lds_dst) { unsigned keep;
    asm volatile("s_mov_b32 %0, m0\n\ts_mov_b32 m0, %2\n\ts_nop 0\n\tglobal_load_lds_dword %1, off\n\ts_mov_b32 m0, %0" : "=&s"(keep) : "v"(gsrc), "s"(lds_dst) : "memory"); }
#define ATT_WAIT_BAR(N) asm volatile("s_waitcnt vmcnt(" #N ") lgkmcnt(0)\n\ts_barrier" ::: "memory")

__device__ __forceinline__ float max3f(float a, float b, float c) { float r; asm("v_max3_f32 %0, %1, %2, %3" : "=v"(r) : "v"(a), "v"(b), "v"(c)); return r; }
__device__ __forceinline__ float fadd_s(float a, float b) { float r; asm("v_add_f32_e32 %0, %1, %2" : "=v"(r) : "v"(a), "v"(b)); return r; }
struct WaveState { float mref, l; f32x16 o0, o1, negm; };
__device__ __forceinline__ void ws_reset(WaveState& st) { st.mref = 0.f; st.l = 0.f;
#pragma unroll
    for (int r = 0; r < 16; ++r) { st.o0[r] = 0.f; st.o1[r] = 0.f; st.negm[r] = 0.f; } }

template <bool SUB, int PVT = 0>
__device__ __forceinline__ void tile_compute(lds_cptr kslot, const int (&kofs)[4], lds_cptr vslot, const bf16x8 (&qr)[4], const LAS float* tb, bool band, int qpos, int kpos0,
                                             WaveState& st, int& started, int r32, int hi, int lane) {
    f32x16 p0, p1;
    const lds_cptr vb = vslot + ((lane >> 4) & 1) * 32 + (lane & 3) * 8 + (4 * hi + ((lane & 15) >> 2)) * 64;
    bf16x8 kf[8]; f32x4 tt[8];
#pragma unroll
    for (int d0 = 0; d0 < 4; ++d0) { kf[2 * d0] = *(const LAS bf16x8*)(kslot + kofs[d0]); kf[2 * d0 + 1] = *(const LAS bf16x8*)(kslot + kofs[d0] + 4096); }
#pragma unroll
    for (int g = 0; g < 4; ++g) { tt[2 * g] = *(const LAS f32x4*)(tb + 8 * g + 4 * hi); tt[2 * g + 1] = *(const LAS f32x4*)(tb + 32 + 8 * g + 4 * hi); }
    __builtin_amdgcn_sched_barrier(0);
    p0 = __builtin_amdgcn_mfma_f32_32x32x16_bf16(kf[0], qr[0], st.negm, 0, 0, 0);
    p1 = __builtin_amdgcn_mfma_f32_32x32x16_bf16(kf[1], qr[0], st.negm, 0, 0, 0);
#pragma unroll
    for (int d0 = 1; d0 < 4; ++d0) {
        p0 = __builtin_amdgcn_mfma_f32_32x32x16_bf16(kf[2 * d0], qr[d0], p0, 0, 0, 0);
        p1 = __builtin_amdgcn_mfma_f32_32x32x16_bf16(kf[2 * d0 + 1], qr[d0], p1, 0, 0, 0);
    }
    s16x4 vf[16];
#pragma unroll
    for (int ks = 0; ks < 4; ++ks) { vf[4 * ks] = vtr(vb + ks * 1024); vf[4 * ks + 1] = vtr(vb + ks * 1024 + 512); vf[4 * ks + 2] = vtr(vb + 4096 + ks * 1024); vf[4 * ks + 3] = vtr(vb + 4096 + ks * 1024 + 512); }
    __builtin_amdgcn_sched_barrier(0);
#pragma unroll
    for (int g = 0; g < 4; ++g) {
#pragma unroll
        for (int q = 0; q < 4; ++q) { if (SUB) { p0[4 * g + q] -= tt[2 * g][q]; p1[4 * g + q] -= tt[2 * g + 1][q]; } else { p0[4 * g + q] += tt[2 * g][q]; p1[4 * g + q] += tt[2 * g + 1][q]; } } }
    if (band) {
#pragma unroll
        for (int r = 0; r < 16; ++r) { const int kv = kpos0 + crow(r, hi); if (kv > qpos) p0[r] = NEGBIG; if (kv + 32 > qpos) p1[r] = NEGBIG; }
    }
    float rm, rm2;
    { rm = max3f(p0[0], p0[1], p1[0]); rm2 = max3f(p0[2], p0[3], p1[1]); rm = max3f(rm, p1[2], p1[3]);
#pragma unroll
      for (int r = 4; r < 16; r += 4) { rm = max3f(rm, p0[r], p0[r + 1]); rm2 = max3f(rm2, p0[r + 2], p0[r + 3]); rm = max3f(rm, p1[r], p1[r + 1]); rm2 = max3f(rm2, p1[r + 2], p1[r + 3]); }
      rm = fmaxf(rm, rm2); }
    { auto rr = __builtin_amdgcn_permlane32_swap(__float_as_uint(rm), __float_as_uint(rm), false, false); rm = fmaxf(__uint_as_float(rr[0]), __uint_as_float(rr[1])); }
    if (PVT == 3) { st.l += rm; return; }
    if (started && __all(rm < -32.0f)) return;
    started = 1;
    if (__any(rm > 8.0f)) {
        const float dl = fmaxf(rm, 0.f), f = __builtin_amdgcn_exp2f(-dl);
        st.mref += dl; st.l *= f;
#pragma unroll
        for (int r = 0; r < 16; ++r) { p0[r] -= dl; p1[r] -= dl; st.o0[r] *= f; st.o1[r] *= f; st.negm[r] = -st.mref; }
    }
#pragma unroll
    for (int r = 0; r < 16; ++r) { p0[r] = __builtin_amdgcn_exp2f(p0[r]); p1[r] = __builtin_amdgcn_exp2f(p1[r]); }
    { float sa = p0[0], sb = p1[0];
#pragma unroll
      for (int r = 1; r < 16; ++r) { sa += p0[r]; asm volatile("" : "+v"(sa)); sb += p1[r]; asm volatile("" : "+v"(sb)); }
      st.l += sa + sb; }
    u32x4 pw[4];
#pragma unroll
    for (int s = 0; s < 2; ++s)
#pragma unroll
        for (int j = 0; j < 4; ++j) { pw[s][j] = cvt_pk_bf16(p0[8 * s + 2 * j], p0[8 * s + 2 * j + 1]); pw[2 + s][j] = cvt_pk_bf16(p1[8 * s + 2 * j], p1[8 * s + 2 * j + 1]); }
    __builtin_amdgcn_sched_barrier(0);
#pragma unroll
    for (int ks = 0; ks < 4; ++ks) {
        const s16x4 a_lo = vf[4 * ks], a_hi = vf[4 * ks + 1], b_lo = vf[4 * ks + 2], b_hi = vf[4 * ks + 3];
        const bf16x8 va = (bf16x8){a_lo[0], a_lo[1], a_lo[2], a_lo[3], a_hi[0], a_hi[1], a_hi[2], a_hi[3]};
        const bf16x8 vb2 = (bf16x8){b_lo[0], b_lo[1], b_lo[2], b_lo[3], b_hi[0], b_hi[1], b_hi[2], b_hi[3]};
        const bf16x8 pf = __builtin_bit_cast(bf16x8, pw[ks]);
        st.o0 = __builtin_amdgcn_mfma_f32_32x32x16_bf16(va, pf, st.o0, 0, 0, 0);
        st.o1 = __builtin_amdgcn_mfma_f32_32x32x16_bf16(vb2, pf, st.o1, 0, 0, 0);
    }
}

__device__ __forceinline__ void stage_o(const WaveState& st, float inv_l, LAS char* stg, int r32, int hi) {
#pragma unroll
    for (int g = 0; g < 4; ++g) {
        u32x2 w0, w1;
        w0.x = cvt_pk_bf16(st.o0[4 * g] * inv_l, st.o0[4 * g + 1] * inv_l); w0.y = cvt_pk_bf16(st.o0[4 * g + 2] * inv_l, st.o0[4 * g + 3] * inv_l);
        w1.x = cvt_pk_bf16(st.o1[4 * g] * inv_l, st.o1[4 * g + 1] * inv_l); w1.y = cvt_pk_bf16(st.o1[4 * g + 2] * inv_l, st.o1[4 * g + 3] * inv_l);
        *(LAS u32x2*)(stg + r32 * 128 + ((g ^ (r32 & 7)) * 16) + 8 * hi) = w0;
        *(LAS u32x2*)(stg + r32 * 128 + (((4 + g) ^ (r32 & 7)) * 16) + 8 * hi) = w1;
    }
}

struct Desc { int type, branch, dsh, res, lb, qb, jb, je; };
template <int NP>
__device__ __forceinline__ Desc get_desc(int u, int sub, const LAS int* js) {
    constexpr int DU = 12 / NP, BPB = 4 / NP;
    Desc q;
    if (u < DU) { q.type = 0; q.branch = u / BPB; const int blk = sub * BPB + (u - q.branch * BPB); q.dsh = 2 * q.branch; const int nlb = 32 >> q.dsh; q.res = blk >> (5 - q.dsh); q.lb = blk & (nlb - 1); q.qb = 0; q.jb = q.lb == 0 ? 2 : 0; q.je = 6; }
    else { q.type = 1; q.branch = 0; q.dsh = 0; q.res = 0; q.lb = 0; q.qb = sub + 8 * NP * (u - DU); q.jb = __builtin_amdgcn_readfirstlane(js[u - DU]); q.je = 4 * q.qb + 4; }
    return q;
}
__device__ __forceinline__ void wait_vm_bar(int c) {
    switch (c) { case 1: ATT_WAIT_BAR(1); break; case 2: ATT_WAIT_BAR(2); break; case 3: ATT_WAIT_BAR(3); break; case 4: ATT_WAIT_BAR(4); break; case 5: ATT_WAIT_BAR(5); break; case 6: ATT_WAIT_BAR(6); break; case 7: ATT_WAIT_BAR(7); break; case 8: ATT_WAIT_BAR(8); break; case 9: ATT_WAIT_BAR(9); break; case 10: ATT_WAIT_BAR(10); break; case 11: ATT_WAIT_BAR(11); break; case 12: ATT_WAIT_BAR(12); break; case 13: ATT_WAIT_BAR(13); break; case 14: ATT_WAIT_BAR(14); break; case 15: ATT_WAIT_BAR(15); break; case 16: ATT_WAIT_BAR(16); break; case 17: ATT_WAIT_BAR(17); break; case 18: ATT_WAIT_BAR(18); break; case 19: ATT_WAIT_BAR(19); break; case 20: ATT_WAIT_BAR(20); break; case 21: ATT_WAIT_BAR(21); break; case 22: ATT_WAIT_BAR(22); break; case 23: ATT_WAIT_BAR(23); break; case 24: ATT_WAIT_BAR(24); break; case 25: ATT_WAIT_BAR(25); break; case 26: ATT_WAIT_BAR(26); break; case 27: ATT_WAIT_BAR(27); break; case 28: ATT_WAIT_BAR(28); break; case 29: ATT_WAIT_BAR(29); break; case 30: ATT_WAIT_BAR(30); break; default: ATT_WAIT_BAR(0); break; }
}
__device__ __forceinline__ void wait_vm(int c) {
    switch (c) { case 1: asm volatile("s_waitcnt vmcnt(1)" ::: "memory"); break; case 2: asm volatile("s_waitcnt vmcnt(2)" ::: "memory"); break; case 3: asm volatile("s_waitcnt vmcnt(3)" ::: "memory"); break; case 4: asm volatile("s_waitcnt vmcnt(4)" ::: "memory"); break; case 5: asm volatile("s_waitcnt vmcnt(5)" ::: "memory"); break; case 6: asm volatile("s_waitcnt vmcnt(6)" ::: "memory"); break; case 7: asm volatile("s_waitcnt vmcnt(7)" ::: "memory"); break; case 8: asm volatile("s_waitcnt vmcnt(8)" ::: "memory"); break; case 9: asm volatile("s_waitcnt vmcnt(9)" ::: "memory"); break; case 10: asm volatile("s_waitcnt vmcnt(10)" ::: "memory"); break; case 11: asm volatile("s_waitcnt vmcnt(11)" ::: "memory"); break; case 12: asm volatile("s_waitcnt vmcnt(12)" ::: "memory"); break; case 13: asm volatile("s_waitcnt vmcnt(13)" ::: "memory"); break; case 14: asm volatile("s_waitcnt vmcnt(14)" ::: "memory"); break; case 15: asm volatile("s_waitcnt vmcnt(15)" ::: "memory"); break; case 16: asm volatile("s_waitcnt vmcnt(16)" ::: "memory"); break; case 17: asm volatile("s_waitcnt vmcnt(17)" ::: "memory"); break; case 18: asm volatile("s_waitcnt vmcnt(18)" ::: "memory"); break; case 19: asm volatile("s_waitcnt vmcnt(19)" ::: "memory"); break; case 20: asm volatile("s_waitcnt vmcnt(20)" ::: "memory"); break; case 21: asm volatile("s_waitcnt vmcnt(21)" ::: "memory"); break; case 22: asm volatile("s_waitcnt vmcnt(22)" ::: "memory"); break; case 23: asm volatile("s_waitcnt vmcnt(23)" ::: "memory"); break; case 24: asm volatile("s_waitcnt vmcnt(24)" ::: "memory"); break; case 25: asm volatile("s_waitcnt vmcnt(25)" ::: "memory"); break; case 26: asm volatile("s_waitcnt vmcnt(26)" ::: "memory"); break; case 27: asm volatile("s_waitcnt vmcnt(27)" ::: "memory"); break; case 28: asm volatile("s_waitcnt vmcnt(28)" ::: "memory"); break; case 29: asm volatile("s_waitcnt vmcnt(29)" ::: "memory"); break; case 30: asm volatile("s_waitcnt vmcnt(30)" ::: "memory"); break; default: if (c <= 0) asm volatile("s_waitcnt vmcnt(0)" ::: "memory"); else asm volatile("s_waitcnt vmcnt(30)" ::: "memory"); break; }
}
constexpr int L_C = 2 * NSLOT * SLOTB;
constexpr int L_TB3 = L_C + 2048;
constexpr int L_CTL = L_TB3 + 3 * 4 * TABN * 4;
constexpr int L_QS = L_CTL + 256;
constexpr int L_CQ = L_QS + 8 * 4096;

template <int PV, int ONLY, int NP>
__device__ __forceinline__ void attn_phase(int pass, int vcu, const bf16_t* qkv, bf16_t* og, float* lse, bf16_t* of, const float* cf2, const float* nrm, const float* rel_bias, LAS char* lds) {
    const int tid = threadIdx.x, lane = tid & 63, r32 = lane & 31, hi = lane >> 5; const int wid = __builtin_amdgcn_readfirstlane(tid >> 6);
    constexpr int S_ = 8 * NP, DU = 12 / NP, FU = 4 / NP;
    const int u0 = (ONLY == 1) ? DU : 0, u1 = (ONLY == 0) ? DU : DU + FU;
    const int bh = (vcu / S_) * NP + pass, sub = vcu % S_, b = bh >> 3, h = bh & 7;
    const bf16_t* QD = qkv; const bf16_t* KD = qkv + (size_t)1 * M * DH; const bf16_t* VD = qkv + (size_t)2 * M * DH;
    const bf16_t* QF = qkv + (size_t)3 * M * DH; const bf16_t* KF = qkv + (size_t)4 * M * DH; const bf16_t* VF = qkv + (size_t)5 * M * DH;
    const size_t rowb = (size_t)b * T;
    const float* cfh = cf2 + (size_t)bh * T;
    LAS float* tab = (LAS float*)(lds + L_TB3);
    LAS int* js = (LAS int*)(lds + L_CTL);
    const unsigned lds0 = (unsigned)(uintptr_t)lds;
    const int krow_ = 8 * wid + (lane >> 3), kch_ = (lane & 7) ^ ((krow_ >> 1) & 7);
    int kofs[4];
#pragma unroll
    for (int d0 = 0; d0 < 4; ++d0) kofs[d0] = r32 * 128 + (((2 * d0 + hi) ^ ((r32 >> 1) & 7)) * 16);
    if (ONLY != 1) { LAS float* rbh = (LAS float*)(lds + L_QS);
      if (tid < 32) rbh[tid] = rel_bias[tid * NH + h] * LOG2E;
      asm volatile("s_waitcnt vmcnt(0) lgkmcnt(0)" ::: "memory"); __builtin_amdgcn_s_barrier(); asm volatile("" ::: "memory");
      for (int idx = tid; idx < 3 * 4 * TABN; idx += 512) { const int br = idx / (4 * TABN), rem = idx - br * 4 * TABN, s = rem / TABN, u = rem - s * TABN, mm = 255 - (u + s);
        float v = NEGBIG; if (mm >= 0 && mm <= 128) v = rbh[(int)BUCKET[br][mm]];
        tab[idx] = v; } }
    if (ONLY != 0 && wid < FU) {
        const int qb = sub + 8 * NP * wid, jd = 4 * qb;
        const float* nq = nrm + ((size_t)0 * (M / 64) + (size_t)b * 128) * NH * 2;
        const float* nk = nrm + ((size_t)1 * (M / 64) + (size_t)b * 128) * NH * 2;
        float qm = 0.f, km = 0.f;
#pragma unroll
        for (int i = 0; i < 4; ++i) { const float* a = nq + ((size_t)(jd + i) * NH + h) * 2; const float* c_ = nk + ((size_t)(jd + i) * NH + h) * 2;
            qm = fmaxf(qm, a[0] + a[1]); km = fmaxf(km, c_[0] + c_[1]); }
        qm = sqrtf(qm); km = sqrtf(km);
        const float c_t0 = cfh[256 * qb];
        int jmin = jd;
#pragma unroll
        for (int half = 0; half < 2; ++half) { const int j = lane + 64 * half; bool keep = false;
            if (j < jd) { const float c_e = cfh[64 * j + 63]; const float* c_ = nk + ((size_t)j * NH + h) * 2; const float kn = sqrtf(c_[0] + c_[1]);
                const float ub = (c_t0 - c_e) + 1.02f * qm * (kn + km);
                keep = !(ub < -32.0f); }
            const unsigned long long bal = __ballot(keep);
            if (bal) { const int f = __ffsll((long long)bal) - 1 + 64 * half; jmin = f < jmin ? f : jmin; } }
        if (lane == 0) js[wid] = jmin;
    }
    asm volatile("s_waitcnt vmcnt(0) lgkmcnt(0)" ::: "memory"); __builtin_amdgcn_s_barrier(); asm volatile("" ::: "memory");
    int total = 0;
#pragma unroll 1
    for (int u = u0; u < u1; ++u) { const Desc q = get_desc<NP>(u, sub, js); total += q.je - q.jb; }
    int iu = u0, nis = 0, isl = 0; Desc iq = get_desc<NP>(u0, sub, js); int ij = iq.jb;
    const bf16_t* kb_; const bf16_t* vb_; const float* cb_; long tstr;
    const size_t bhD = (size_t)bh * 16 * 512, bhF = (size_t)bh * T;
#define ROWD(t_) ((long)bhD + (long)((t_) & 15) * 512 + (long)((t_) >> 4))
#define SET_ISSUE() do { if (iq.type == 0) { const int d_ = (PV == 6) ? 1 : (1 << iq.dsh); const int kl0 = 256 * iq.lb - 128; \
            const int tk_ = (kl0 + krow_) * d_ + iq.res, tv_ = (kl0 + 16 * (wid & 3) + (lane >> 2)) * d_ + iq.res; \
            kb_ = KD + ROWD(tk_) * HD + kch_ * 8; \
            vb_ = VD + ROWD(tv_) * HD + (wid >> 2) * 32 + (lane & 3) * 8; \
            cb_ = cfh + lane; tstr = (long)4 * d_ * HD; } \
        else { kb_ = KF + ((long)bhF + krow_) * HD + kch_ * 8; vb_ = VF + ((long)bhF + 16 * (wid & 3) + (lane >> 2)) * HD + (wid >> 2) * 32 + (lane & 3) * 8; \
            cb_ = cfh + lane; tstr = (long)64 * HD; } } while (0)
#define ISSUE() do { if (iu < u1) { const int sl_ = isl; const int aj_ = iq.type ? (iq.je - 1 - (ij - iq.jb)) : ij; \
            glds16(kb_ + (long)aj_ * tstr, (unsigned)__builtin_amdgcn_readfirstlane(lds0 + L_K + sl_ * SLOTB + wid * 1024)); \
            glds16(vb_ + (long)aj_ * tstr, (unsigned)__builtin_amdgcn_readfirstlane(lds0 + L_V + sl_ * SLOTB + wid * 1024)); \
            glds4(cb_ + (iq.type ? 64 * aj_ : 0), (unsigned)__builtin_amdgcn_readfirstlane(lds0 + L_C + sl_ * 256)); \
            ++nis; isl = (isl == NSLOT - 1) ? 0 : isl + 1; ++ij; if (ij == iq.je) { ++iu; if (iu < u1) { iq = get_desc<NP>(iu, sub, js); ij = iq.jb; SET_ISSUE(); } } } } while (0)
    SET_ISSUE();
    int cu = u0; Desc cq_ = get_desc<NP>(u0, sub, js); int cj = cq_.jb;
#define QDMA(dq) do { const int rq_ = (dq.type == 0) ? ((256 * dq.lb + 32 * wid + r32) << dq.dsh) + dq.res : 256 * dq.qb + 32 * wid + r32; \
        const bf16_t* qrow_ = (dq.type == 0 ? QD + ROWD(rq_) * HD : QF + ((long)bhF + rq_) * HD) + hi * 8; \
        _Pragma("unroll") for (int d0 = 0; d0 < 4; ++d0) glds16(qrow_ + d0 * 16, (unsigned)__builtin_amdgcn_readfirstlane(lds0 + L_QS + wid * 4096 + d0 * 1024)); \
        glds4(cfh + (dq.type ? rq_ : r32), (unsigned)__builtin_amdgcn_readfirstlane(lds0 + L_CQ + wid * 256)); } while (0)
#define QREAD(dq) do { _Pragma("unroll") for (int d0 = 0; d0 < 4; ++d0) qr[d0] = *(const LAS bf16x8*)(lds + L_QS + wid * 4096 + d0 * 1024 + lane * 16); \
        } while (0)
    bf16x8 qr[4];
    QDMA(cq_);
    asm volatile("s_waitcnt vmcnt(0)" ::: "memory");
    QREAD(cq_);
    asm volatile("s_waitcnt lgkmcnt(0)" ::: "memory");
    ISSUE(); ISSUE(); ISSUE(); ISSUE(); ISSUE();
    WaveState st; ws_reset(st); int started = 0;
    int extra = 0, qsteps = 0, csl = 0, nis_q = 0;
#pragma unroll 1
    for (int n = 0; n < total; ++n) {
        const int ahead = nis - 1 - n;
        if (PV < 2) { wait_vm_bar(3 * ahead + extra + (qsteps > 0 ? 5 : 0)); extra = 0; if (qsteps > 0) --qsteps;
        ISSUE(); } else { ATT_WAIT_BAR(0); if (iu < u1) { ++nis; isl = (isl == NSLOT - 1) ? 0 : isl + 1; ++ij; if (ij == iq.je) { ++iu; if (iu < u1) { iq = get_desc<NP>(iu, sub, js); ij = iq.jb; } } } }
        const bool lastt = (cj == cq_.je - 1);
        if (cj == cq_.jb && cu + 1 < u1) { const Desc nq_ = get_desc<NP>(cu + 1, sub, js); QDMA(nq_); qsteps = PF; nis_q = nis; }
        const int sl = csl; csl = (csl == NSLOT - 1) ? 0 : csl + 1;
        const int aj = cq_.type ? (cq_.je - 1 - (cj - cq_.jb)) : cj;
        if (ONLY != 1 && (ONLY == 0 || cq_.type == 0)) {
            const int wlo = wid >> 1;
            if (PV != 1 && PV != 5 && cj >= wlo && cj <= wlo + 2) {
                const int jj = cj - wlo; const int z0 = 127 - 32 * (wid & 1) - r32 + 64 * jj, s = z0 & 3;
                const LAS float* tb = tab + (cq_.branch * 4 + s) * TABN + (z0 - s);
                tile_compute<false, PV>((lds_cptr)(lds + L_K + sl * SLOTB), kofs, (lds_cptr)(lds + L_V + sl * SLOTB), qr, tb, false, 0, 0, st, started, r32, hi, lane);
            }
        } else if (ONLY != 0) {
            const int qfirst = 256 * cq_.qb + 32 * wid;
            if (PV != 1 && PV != 5 && 64 * aj <= qfirst + 31) {
                const bool band = (64 * aj + 63 > qfirst);
                tile_compute<true, PV>((lds_cptr)(lds + L_K + sl * SLOTB), kofs, (lds_cptr)(lds + L_V + sl * SLOTB), qr, (const LAS float*)(lds + L_C + sl * 256), band, qfirst + r32, 64 * aj, st, started, r32, hi, lane);
            }
        }
        ++cj;
        if (lastt) {
            float lt = st.l; { auto rr = __builtin_amdgcn_permlane32_swap(__float_as_uint(lt), __float_as_uint(lt), false, false); lt = __uint_as_float(rr[0]) + __uint_as_float(rr[1]); }
            const Desc od = cq_;
            ++cu;
            if (cu < u1) { cq_ = get_desc<NP>(cu, sub, js); cj = cq_.jb;
                wait_vm(3 * (nis - nis_q));
                QREAD(cq_); }
            asm volatile("s_waitcnt lgkmcnt(0)" ::: "memory");
            LAS char* stg = lds + L_QS + wid * 4096;
            stage_o(st, 1.0f / lt, stg, r32, hi);
            asm volatile("s_waitcnt lgkmcnt(0)" ::: "memory");
            { const int rsub = lane >> 3, c16 = lane & 7;
#pragma unroll
              for (int i = 0; i < 4; ++i) { const int rw = i * 8 + rsub; const u32x4 v = *(const LAS u32x4*)(stg + rw * 128 + ((c16 ^ (rw & 7)) * 16));
                if (od.type == 0) { const size_t orow = rowb + (((size_t)(256 * od.lb + 32 * wid + rw)) << od.dsh) + od.res; *(u32x4*)(og + ((size_t)od.branch * M + orow) * PITCH + h * HD + c16 * 8) = v; }
                else { *(u32x4*)(of + (rowb + 256 * od.qb + 32 * wid + rw) * PITCH + h * HD + c16 * 8) = v; } } }
            if (od.type == 0) { const size_t orow = rowb + (((size_t)(256 * od.lb + 32 * wid + r32)) << od.dsh) + od.res;
                if (hi == 0) lse[((size_t)od.branch * M + orow) * NH + h] = st.mref + __builtin_amdgcn_logf(lt);
                extra = 5; } else { extra = 4; }
            asm volatile("s_waitcnt lgkmcnt(0)" ::: "memory");
            ws_reset(st); started = 0;
        }
    }
#undef ROWD
#undef SET_ISSUE
#undef ISSUE
#undef QDMA
#undef QREAD
    asm volatile("s_waitcnt vmcnt(0) lgkmcnt(0)\n\ts_barrier" ::: "memory");
}

__device__ __forceinline__ void dil_stream(int vcu, const bf16_t* qkv, bf16_t* og, float* lse, const float* cf2, const float* rel_bias, LAS char* lds) {
    const int tid = threadIdx.x, lane = tid & 63, r32 = lane & 31, hi = lane >> 5; const int wid = __builtin_amdgcn_readfirstlane(tid >> 6);
    constexpr int NU = 12;
    const int bh = vcu >> 3, sub = vcu & 7, b = bh >> 3, h = bh & 7, wlo = wid >> 1;
    const bf16_t* QD = qkv; const bf16_t* KD = qkv + (size_t)1 * M * DH; const bf16_t* VD = qkv + (size_t)2 * M * DH;
    const size_t rowb = (size_t)b * T;
    const float* cfh = cf2 + (size_t)bh * T;
    LAS float* tab = (LAS float*)(lds + L_TB3);
    const unsigned lds0 = (unsigned)(uintptr_t)lds;
    const int krow_ = 8 * wid + (lane >> 3), kch_ = (lane & 7) ^ ((krow_ >> 1) & 7);
    int kofs[4];
#pragma unroll
    for (int d0 = 0; d0 < 4; ++d0) kofs[d0] = r32 * 128 + (((2 * d0 + hi) ^ ((r32 >> 1) & 7)) * 16);
    { LAS float* rbh = (LAS float*)(lds + L_QS);
      if (tid < 32) rbh[tid] = rel_bias[tid * NH + h] * LOG2E;
      asm volatile("s_waitcnt vmcnt(0) lgkmcnt(0)" ::: "memory"); __builtin_amdgcn_s_barrier(); asm volatile("" ::: "memory");
      for (int idx = tid; idx < 3 * 4 * TABN; idx += 512) { const int br = idx / (4 * TABN), rem = idx - br * 4 * TABN, s = rem / TABN, u = rem - s * TABN, mm = 255 - (u + s);
        float v = NEGBIG; if (mm >= 0 && mm <= 128) v = rbh[(int)BUCKET[br][mm]];
        tab[idx] = v; } }
    asm volatile("s_waitcnt vmcnt(0) lgkmcnt(0)" ::: "memory"); __builtin_amdgcn_s_barrier(); asm volatile("" ::: "memory");
    const size_t bhD = (size_t)bh * 16 * 512;
#define ROWD(t_) ((long)bhD + (long)((t_) & 15) * 512 + (long)((t_) >> 4))
    int vm_issued = 0, vm_mark0 = 0, vm_mark1 = 0, vm_mark2 = 0, qmark = 0;
#define UDESC(u_, BR, DSH, RES, LB) const int BR = (u_) >> 2, DSH = 2 * BR, blk_##BR = sub * 4 + ((u_) & 3), RES = blk_##BR >> (5 - DSH), LB = blk_##BR & ((32 >> DSH) - 1)
#define ISSUE_TILE(u_, j_, sp_) do { if ((u_) >= 0 && (u_) < NU) { UDESC(u_, br_, dsh_, res_, lb_); if (!((lb_) == 0 && (j_) < 2)) { const int d_ = 1 << dsh_; const int kl_ = 256 * lb_ - 128 + 64 * (j_); \
            const int tk_ = (kl_ + krow_) * d_ + res_, tv_ = (kl_ + 16 * (wid & 3) + (lane >> 2)) * d_ + res_; \
            glds16(KD + ROWD(tk_) * HD + kch_ * 8, (unsigned)__builtin_amdgcn_readfirstlane(lds0 + L_K + (sp_) * SLOTB + wid * 1024)); \
            glds16(VD + ROWD(tv_) * HD + (wid >> 2) * 32 + (lane & 3) * 8, (unsigned)__builtin_amdgcn_readfirstlane(lds0 + L_V + (sp_) * SLOTB + wid * 1024)); \
            vm_issued += 2; } } } while (0)
#define ISSUE_STEP(k_) do { const int k3_ = (k_) % 3, ku_ = (k_) / 3; ISSUE_TILE(ku_, k3_, 2 * k3_); ISSUE_TILE(ku_ - 1, k3_ + 3, 2 * k3_ + 1); \
        if (k3_ == 0) vm_mark0 = vm_issued; else if (k3_ == 1) vm_mark1 = vm_issued; else vm_mark2 = vm_issued; } while (0)
#define QDMA_U(u_) do { UDESC(u_, brq_, dshq_, resq_, lbq_); const int rq_ = ((256 * lbq_ + 32 * wid + r32) << dshq_) + resq_; \
        const bf16_t* qrow_ = QD + ROWD(rq_) * HD + hi * 8; \
        _Pragma("unroll") for (int d0 = 0; d0 < 4; ++d0) glds16(qrow_ + d0 * 16, (unsigned)__builtin_amdgcn_readfirstlane(lds0 + L_QS + wid * 4096 + d0 * 1024)); \
        vm_issued += 4; qmark = vm_issued; } while (0)
    bf16x8 qr[4];
    QDMA_U(0);
    ISSUE_STEP(0); ISSUE_STEP(1);
    WaveState st; ws_reset(st); int started = 0;
    constexpr int NSTEP = 3 * NU + 4;
#pragma unroll 1
    for (int k = 0; k < NSTEP; ++k) {
        const int k3 = k % 3;
        { const int mk = (k3 == 0) ? vm_mark0 : (k3 == 1) ? vm_mark1 : vm_mark2; int c = vm_issued - mk; c = c > 30 ? 30 : c; wait_vm_bar(c); }
        if (k + 2 < NSTEP) ISSUE_STEP(k + 2);
        const bool isA = (wlo <= k3); const int u = isA ? k / 3 : k / 3 - 1; const int j = isA ? k3 : k3 + 3; const int jj = j - wlo; const int sp = 2 * k3 + (isA ? 0 : 1);
        if (jj == 0) {
            if (u > 0 && u <= NU) {
                UDESC(u - 1, bro_, dsho_, reso_, lbo_);
                float lt = st.l; { auto rr = __builtin_amdgcn_permlane32_swap(__float_as_uint(lt), __float_as_uint(lt), false, false); lt = __uint_as_float(rr[0]) + __uint_as_float(rr[1]); }
                const float il = 1.0f / lt;
                const size_t orow = rowb + (((size_t)(256 * lbo_ + 32 * wid + r32)) << dsho_) + reso_;
                bf16_t* op = og + ((size_t)bro_ * M + orow) * PITCH + h * HD;
#pragma unroll
                for (int g = 0; g < 4; ++g) { u32x2 w0, w1;
                    w0.x = cvt_pk_bf16(st.o0[4 * g] * il, st.o0[4 * g + 1] * il); w0.y = cvt_pk_bf16(st.o0[4 * g + 2] * il, st.o0[4 * g + 3] * il);
                    w1.x = cvt_pk_bf16(st.o1[4 * g] * il, st.o1[4 * g + 1] * il); w1.y = cvt_pk_bf16(st.o1[4 * g + 2] * il, st.o1[4 * g + 3] * il);
                    *(u32x2*)(op + 8 * g + 4 * hi) = w0; *(u32x2*)(op + 32 + 8 * g + 4 * hi) = w1; }
                lse[((size_t)bro_ * M + orow) * NH + h] = st.mref + __builtin_amdgcn_logf(lt);
                vm_issued += 9;
                ws_reset(st); started = 0;
            }
            if (u >= 0 && u < NU) {
                { int c = vm_issued - qmark; wait_vm(c > 30 ? 30 : c); }
#pragma unroll
                for (int d0 = 0; d0 < 4; ++d0) qr[d0] = *(const LAS bf16x8*)(lds + L_QS + wid * 4096 + d0 * 1024 + lane * 16);
                asm volatile("s_waitcnt lgkmcnt(0)" ::: "memory");
                if (u + 1 < NU) QDMA_U(u + 1);
            }
        }
        if (u >= 0 && u < NU) {
            UDESC(u, brc_, dshc_, resc_, lbc_);
            if (!(lbc_ == 0 && j < 2)) {
                const int z0 = 127 - 32 * (wid & 1) - r32 + 64 * jj, s = z0 & 3;
                const LAS float* tb = tab + (brc_ * 4 + s) * TABN + (z0 - s);
                tile_compute<false, 0>((lds_cptr)(lds + L_K + sp * SLOTB), kofs, (lds_cptr)(lds + L_V + sp * SLOTB), qr, tb, false, 0, 0, st, started, r32, hi, lane);
            }
        }
    }
#undef ROWD
#undef UDESC
#undef ISSUE_TILE
#undef ISSUE_STEP
#undef QDMA_U
    asm volatile("s_waitcnt vmcnt(0) lgkmcnt(0)\n\ts_barrier" ::: "memory");
}
}
constexpr int NWAVES = 8;
constexpr size_t MiB = 1u << 20;
constexpr size_t WS_CTL = 0, CTL_ZERO_BYTES = 1 * MiB;
constexpr size_t WS_RSTD1 = 1 * MiB;
constexpr size_t WS_CTOT = WS_RSTD1 + 128 * 1024;
constexpr size_t WS_NRM = WS_CTOT + 8 * 1024;
constexpr size_t WS_WR = WS_NRM + 64 * 1024;
constexpr size_t WS_CL = 2 * MiB;
constexpr size_t WS_LSE = 3 * MiB;
constexpr size_t WS_WIN = 6 * MiB;
constexpr size_t WS_WOUT = 12 * MiB;
constexpr size_t WS_WGU = 14 * MiB;
constexpr size_t WS_WD = 46 * MiB;
constexpr size_t WS_LTOK = 62 * MiB, WS_LW = 66 * MiB, WS_LRS = 70 * MiB;
constexpr size_t WS_TMAP = 75 * MiB;
constexpr size_t WS_CF2 = 74 * MiB;
constexpr size_t WS_XB = 76 * MiB;
constexpr size_t WS_QKV = 140 * MiB;
constexpr size_t WS_ON = 204 * MiB;
constexpr size_t WS_OG = 332 * MiB;
constexpr size_t WS_OF = 428 * MiB;
constexpr size_t WS_H = 332 * MiB;
constexpr size_t WS_X1B = 370 * MiB;
constexpr size_t WS_END = 460 * MiB;
constexpr int CW_BAR = 4096;
constexpr int CW_ECNT = 16384;

constexpr int RING_BYTES = 131072;
constexpr int MISC_OFF = 163840 - 2048;
constexpr int LDS_BYTES = 163840;

#define RLX_AGENT __ATOMIC_RELAXED, __HIP_MEMORY_SCOPE_AGENT

#define XB_TMO      128
#define XB_XCNT(j)  (256  + 64 * (j))
#define XB_XSUB(j)  (1280 + 64 * (j))
#define XB_XGEN(j)  (2304 + 64 * (j))
#define XB_TOP      3328
#define XB_TOPGEN   3392
#define XCD_BAR_WORDS 3456
#define XB_SPIN_CAP (1u << 18)
__device__ __forceinline__ unsigned xb_ld(unsigned* p)              { return __hip_atomic_load(p, __ATOMIC_RELAXED, __HIP_MEMORY_SCOPE_AGENT); }
__device__ __forceinline__ unsigned xb_add(unsigned* p, unsigned v) { return __hip_atomic_fetch_add(p, v, __ATOMIC_RELAXED, __HIP_MEMORY_SCOPE_AGENT); }
__device__ __forceinline__ unsigned xb_xcc_id() { return (unsigned)__builtin_amdgcn_s_getreg((3 << 11) | 20) & 0xFu; }
#define XB_SPIN(cond, bar) do { unsigned _sp = 0; while (cond) { __builtin_amdgcn_s_sleep(1); \
    if ((++_sp & 255u) == 0u) { if (xb_ld(&(bar)[XB_TMO])) break; if (_sp > XB_SPIN_CAP) { atomicAdd(&(bar)[XB_TMO], 1u); break; } } } } while (0)
struct XcdBarrier { unsigned* bar; unsigned x; volatile LAS unsigned* st; };
__device__ __forceinline__ XcdBarrier xcd_barrier_post(unsigned* bar, volatile LAS unsigned* st) {
    XcdBarrier b; b.bar = bar; b.x = xb_xcc_id(); b.st = st;
    if (threadIdx.x == 0) (void)xb_add(&bar[XB_XCNT(b.x)], 1u);
    return b;
}
__device__ __forceinline__ void xcd_barrier_complete(unsigned* bar, unsigned x, unsigned& nloc, unsigned& nx) {
    const unsigned G = gridDim.x * gridDim.y * gridDim.z;
    unsigned sum, cnt, mine, sp = 0u;
    for (;;) {
        sum = 0u; cnt = 0u; mine = 0u;
#pragma unroll
        for (unsigned j = 0; j < 16; ++j) { const unsigned c = xb_ld(&bar[XB_XCNT(j)]); sum += c; cnt += (c > 0u) ? 1u : 0u; mine = (j == x) ? c : mine; }
        if (sum == G) break;
        __builtin_amdgcn_s_sleep(1);
        if ((++sp & 255u) == 0u) { if (xb_ld(&bar[XB_TMO])) break; if (sp > XB_SPIN_CAP) { atomicAdd(&bar[XB_TMO], 1u); break; } }
    }
    nloc = mine > 0u ? mine : 1u; nx = cnt > 0u ? cnt : 1u;
}
__device__ __forceinline__ void xcd_barrier(const XcdBarrier& b) {
    asm volatile("s_waitcnt vmcnt(0)" ::: "memory");
    __syncthreads();
    if (threadIdx.x == 0) {
        unsigned* bar = b.bar;
        __builtin_amdgcn_s_waitcnt(0);
        unsigned nloc = b.st[0], nx = b.st[1];
        if (nloc == 0u) { xcd_barrier_complete(bar, b.x, nloc, nx); b.st[0] = nloc; b.st[1] = nx; }
        const unsigned old = xb_add(&bar[XB_XSUB(b.x)], 1u);
        const unsigned gen = old / nloc;
        if (old + 1u == (gen + 1u) * nloc) {
            __builtin_amdgcn_fence(__ATOMIC_RELEASE, "agent");
            asm volatile("s_waitcnt vmcnt(0)" ::: "memory");
            const unsigned og = xb_add(&bar[XB_TOP], 1u);
            const unsigned tg = og / nx;
            if (og + 1u == (tg + 1u) * nx) xb_add(&bar[XB_TOPGEN], 1u);
            else XB_SPIN(xb_ld(&bar[XB_TOPGEN]) == tg, bar);
            __builtin_amdgcn_fence(__ATOMIC_ACQUIRE, "agent");
            xb_add(&bar[XB_XGEN(b.x)], 1u);
            asm volatile("s_waitcnt vmcnt(0)" ::: "memory");
        } else {
            XB_SPIN(xb_ld(&bar[XB_XGEN(b.x)]) == gen, bar);
            __builtin_amdgcn_fence(__ATOMIC_ACQUIRE, "agent");
            asm volatile("s_waitcnt vmcnt(0)" ::: "memory");
        }
    }
    __syncthreads();
}

__device__ __forceinline__ float wave_sum(float v) {
#pragma unroll
    for (int o = 1; o < 64; o <<= 1) v += __shfl_xor(v, o);
    return v;
}

struct TItem { const float* Wc; const float* gain; bf16_t* WT; int ldn, k0, ldk, dest_row0, mode; };
__device__ __forceinline__ void p0_titem_load(const TItem& t, float (&v)[32], int lane) {
    const float* src = t.Wc + (size_t)(t.k0 + (lane >> 5)) * t.ldn + (lane & 31);
#pragma unroll
    for (int i = 0; i < 32; ++i) v[i] = src[(size_t)(2 * i) * t.ldn];
}
__device__ __forceinline__ void p0_titem_store(const TItem& t, float (&v)[32], LAS float* scr, int lane) {
    if (t.gain) {
#pragma unroll
        for (int i = 0; i < 32; ++i) v[i] *= t.gain[t.k0 + 2 * i + (lane >> 5)]; }
#pragma unroll
    for (int i = 0; i < 32; ++i) scr[(2 * i + (lane >> 5)) * 33 + (lane & 31)] = v[i];
    asm volatile("s_waitcnt lgkmcnt(0)" ::: "memory");
    const int c = lane & 7;
#pragma unroll
    for (int j = 0; j < 4; ++j) { const int n = (lane >> 3) + 8 * j; const LAS float* s = scr + (8 * c) * 33 + n;
        u32x4 o; o.x = cvt_pk_bf16(s[0 * 33], s[1 * 33]); o.y = cvt_pk_bf16(s[2 * 33], s[3 * 33]); o.z = cvt_pk_bf16(s[4 * 33], s[5 * 33]); o.w = cvt_pk_bf16(s[6 * 33], s[7 * 33]);
        int drow = t.dest_row0 + n; if (t.mode == 1) { const int oc = drow; drow = (oc & ~255) + 128 * ((oc >> 3) & 1) + 32 * ((oc >> 6) & 3) + 8 * ((oc >> 4) & 3) + (oc & 7); }
        *(u32x4*)(t.WT + (size_t)drow * t.ldk + t.k0 + 8 * c) = o; }
    asm volatile("s_waitcnt lgkmcnt(0)" ::: "memory");
}

struct Args { const float* in[17]; float* out; unsigned char* ws; int ph_lo, ph_hi; };

#ifndef MK_SKIP_MOE
#define MK_SKIP_MOE 0
#endif
constexpr int N_PHASES = 9;

__global__ void __launch_bounds__(NWAVES * 64, 2) hymba_fwd(Args args) {
    extern __shared__ __attribute__((aligned(16))) unsigned char lds_raw[];
    LAS unsigned char* lds = (LAS unsigned char*)lds_raw;
    const int tid = threadIdx.x, lane = tid & 63; const int wave = __builtin_amdgcn_readfirstlane(tid >> 6);
    const int G = gridDim.x; const int bx = blockIdx.x; const int vcu = (G % 8 == 0) ? (bx % 8) * (G / 8) + bx / 8 : bx;
    unsigned char* ws = args.ws;
    unsigned* ctl = (unsigned*)(ws + WS_CTL);
    const float* x = args.in[0]; const float* w_in = args.in[1]; const float* b_forget = args.in[2]; const float* attn_norm = args.in[3];
    const float* on_dil = args.in[4]; const float* on_fox = args.in[5]; const float* w_out = args.in[6]; const float* ffn_norm = args.in[7];
    const float* w_rg = args.in[8]; const float* b_rg = args.in[9]; const float* w_re = args.in[10]; const float* b_re = args.in[11];
    const float* w_gate = args.in[12]; const float* w_up = args.in[13]; const float* w_down = args.in[14]; const float* rel_bias = args.in[15]; const float* final_norm = args.in[16];
    float* rstd1 = (float*)(ws + WS_RSTD1); float* ctot = (float*)(ws + WS_CTOT); float* nrm = (float*)(ws + WS_NRM); bf16_t* WrT = (bf16_t*)(ws + WS_WR);
    float* cl = (float*)(ws + WS_CL); float* lse = (float*)(ws + WS_LSE); float* cf2 = (float*)(ws + WS_CF2);
    bf16_t* WinT = (bf16_t*)(ws + WS_WIN); bf16_t* WoutT = (bf16_t*)(ws + WS_WOUT); bf16_t* WguT = (bf16_t*)(ws + WS_WGU); bf16_t* WdT = (bf16_t*)(ws + WS_WD);
    int* list_tok = (int*)(ws + WS_LTOK); float* list_w = (float*)(ws + WS_LW); float* list_rs = (float*)(ws + WS_LRS); int* tokmap = (int*)(ws + WS_TMAP);
    bf16_t* xb = (bf16_t*)(ws + WS_XB); bf16_t* On = (bf16_t*)(ws + WS_ON);
    bf16_t* qkv = (bf16_t*)(ws + WS_QKV); unsigned char* yslot = (unsigned char*)(ws + WS_QKV);
    bf16_t* og = (bf16_t*)(ws + WS_OG); bf16_t* of = (bf16_t*)(ws + WS_OF); bf16_t* Hb = (bf16_t*)(ws + WS_H); bf16_t* x1b = (bf16_t*)(ws + WS_X1B);

    for (int u = tid; u < (LDS_BYTES - MISC_OFF) / 4; u += NWAVES * 64) ((LAS unsigned*)(lds + MISC_OFF))[u] = 0u;
    __syncthreads();
    const int lo = args.ph_lo, hi_ph = args.ph_hi;
    const bool one_launch = (hi_ph - lo) > 1;
    XcdBarrier bar; bar.bar = ctl + CW_BAR; bar.x = 0; bar.st = nullptr;
    if (one_launch) bar = xcd_barrier_post(ctl + CW_BAR, (volatile LAS unsigned*)(lds + MISC_OFF));
#ifndef PHASE_MASK
#define PHASE_MASK 0x1ff
#endif
#define IN(k) (((PHASE_MASK >> (k)) & 1) && lo <= (k) && (k) < hi_ph)
#define SEAM(k) do { if (IN(k) && IN((k) + 1)) xcd_barrier(bar); } while (0)

    if (IN(0)) {
        {
        LAS float* scr = (LAS float*)(lds + wave * 8704);
        const int gw = vcu * NWAVES + wave, NGW = G * NWAVES;
        constexpr int I_IN = 16 * 96, I_OUT = 16 * 32, I_G = NE * 16 * 8, I_D = NE * 4 * 32;
        constexpr int NIT = I_IN + I_OUT + 2 * I_G + I_D;
#define MK_ITEM(it_, T_) do { int r = (it_); \
            if (r < I_IN) { const int kb = r / 96, nb = r % 96; T_ = TItem{w_in + 32 * nb, attn_norm, WinT, DIN, 64 * kb, D, 32 * nb, 0}; } \
            else if ((r -= I_IN) < I_OUT) { const int kb = r / 32, nb = r % 32; T_ = TItem{w_out + 32 * nb, (kb < 8) ? on_dil : on_fox - DH, WoutT, D, 64 * kb, D, 32 * nb, 0}; } \
            else if ((r -= I_OUT) < 2 * I_G) { const int up = r >= I_G; if (up) r -= I_G; const int e = r / 128, q = r % 128, kb = q / 8, nb = q % 8, n0 = 32 * nb; \
                T_ = TItem{(up ? w_up : w_gate) + (size_t)e * D * DE + n0, ffn_norm, WguT + (size_t)e * 512 * D, DE, 64 * kb, D, (n0 >> 7) * 256 + up * 128 + (n0 & 127), 0}; } \
            else { r -= 2 * I_G; const int e = r / 128, q = r % 128, kb = q / 32, nb = q % 32; \
                T_ = TItem{w_down + (size_t)e * DE * D + 32 * nb, nullptr, WdT + (size_t)e * D * DE, D, 64 * kb, DE, 32 * nb, 1}; } } while (0)
        for (int it = gw; it < NIT; it += 2 * NGW) {
            TItem ta, tb2; float va[32], vb[32];
            MK_ITEM(it, ta); p0_titem_load(ta, va, lane);
            const bool two = (it + NGW < NIT);
            if (two) { MK_ITEM(it + NGW, tb2); p0_titem_load(tb2, vb, lane); }
            p0_titem_store(ta, va, scr, lane);
            if (two) p0_titem_store(tb2, vb, scr, lane);
        }
#undef MK_ITEM
        for (int it = gw * 64 + lane; it < 48 * 128; it += NGW * 64) { const int n = it >> 7, k8 = (it & 127) * 8; float v[8];
#pragma unroll
            for (int q = 0; q < 8; ++q) { const int k = k8 + q; float w = 0.f; if (n < 32) w = w_re[(size_t)k * NE + n]; else if (n < 36) w = w_rg[(size_t)k * NG + (n - 32)]; v[q] = w * ffn_norm[k]; }
            u32x4 o; o.x = cvt_pk_bf16(v[0], v[1]); o.y = cvt_pk_bf16(v[2], v[3]); o.z = cvt_pk_bf16(v[4], v[5]); o.w = cvt_pk_bf16(v[6], v[7]);
            *(u32x4*)(WrT + (size_t)n * D + k8) = o; }
        }
        __syncthreads();
        LAS unsigned short* wfh = (LAS unsigned short*)(lds); LAS unsigned short* wfl = (LAS unsigned short*)(lds + 32768);
        for (int i = tid; i < 4096; i += NWAVES * 64) ((LAS u32x4*)lds)[i] = (u32x4){0u, 0u, 0u, 0u};
        __syncthreads();
        for (int k = tid; k < D; k += NWAVES * 64) { const float gk = attn_norm[k]; const f32x4 a = *(const f32x4*)(w_in + (size_t)k * DIN + NQKV) * gk, b2 = *(const f32x4*)(w_in + (size_t)k * DIN + NQKV + 4) * gk;
            const int ent = ((k >> 5) * 4 + ((k >> 3) & 3)) * 16, j = k & 7;
#pragma unroll
            for (int c = 0; c < 8; ++c) { const float v = c < 4 ? a[c] : b2[c - 4]; const unsigned hw = cvt_pk_bf16(v, 0.f) & 0xffffu; const float hf = __builtin_bit_cast(float, hw << 16);
                const unsigned lw = cvt_pk_bf16(v - hf, 0.f) & 0xffffu; wfh[(ent + c) * 8 + j] = (unsigned short)hw; wfl[(ent + c) * 8 + j] = (unsigned short)lw; } }
        __syncthreads();
        {
        LAS float* lf = (LAS float*)(lds + 65536);
        LAS float* segs = lf + 1024;
        LAS float* rsl = segs + 128 + wave * 16;
        for (int ch = bx; ch < M / 128; ch += G) {
            const int rl = lane & 15, g_ = lane >> 4; const size_t row = (size_t)ch * 128 + wave * 16 + rl;
            const float* xr = x + row * D + 8 * g_; bf16_t* xo = xb + row * D + 8 * g_;
            f32x4 acc = (f32x4){0.f, 0.f, 0.f, 0.f}; float ss = 0.f;
#pragma unroll 8
            for (int kk = 0; kk < 32; ++kk) {
                const f32x4 v0 = *(const f32x4*)(xr + 32 * kk), v1 = *(const f32x4*)(xr + 32 * kk + 4);
                ss += (v0.x * v0.x + v0.y * v0.y) + (v0.z * v0.z + v0.w * v0.w) + (v1.x * v1.x + v1.y * v1.y) + (v1.z * v1.z + v1.w * v1.w);
                u32x4 hw; hw.x = cvt_pk_bf16(v0.x, v0.y); hw.y = cvt_pk_bf16(v0.z, v0.w); hw.z = cvt_pk_bf16(v1.x, v1.y); hw.w = cvt_pk_bf16(v1.z, v1.w);
                *(u32x4*)(xo + 32 * kk) = hw;
                u32x4 lw; lw.x = cvt_pk_bf16(v0.x - bf_lo(hw.x), v0.y - bf_hi(hw.x)); lw.y = cvt_pk_bf16(v0.z - bf_lo(hw.y), v0.w - bf_hi(hw.y));
                lw.z = cvt_pk_bf16(v1.x - bf_lo(hw.z), v1.y - bf_hi(hw.z)); lw.w = cvt_pk_bf16(v1.z - bf_lo(hw.w), v1.w - bf_hi(hw.w));
                const bf16x8 ah = __builtin_bit_cast(bf16x8, hw), al = __builtin_bit_cast(bf16x8, lw);
                const bf16x8 bh = *(const LAS bf16x8*)(lds + (((kk * 4 + g_) * 16 + rl) * 16)), bl = *(const LAS bf16x8*)(lds + 32768 + (((kk * 4 + g_) * 16 + rl) * 16));
                acc = __builtin_amdgcn_mfma_f32_16x16x32_bf16(ah, bh, acc, 0, 0, 0);
                acc = __builtin_amdgcn_mfma_f32_16x16x32_bf16(al, bh, acc, 0, 0, 0);
                acc = __builtin_amdgcn_mfma_f32_16x16x32_bf16(ah, bl, acc, 0, 0, 0);
            }
            ss += __shfl_xor(ss, 16); ss += __shfl_xor(ss, 32);
            const float rs = 1.0f / sqrtf(ss * (1.0f / D) + EPS);
            if (lane < 16) { rsl[lane] = rs; rstd1[row] = rs; }
            asm volatile("s_waitcnt lgkmcnt(0)" ::: "memory");
            if (rl < 8) { const float bfv = b_forget[rl];
#pragma unroll
                for (int i = 0; i < 4; ++i) { const float z = acc[i] * rsl[4 * g_ + i] + bfv; lf[(wave * 16 + 4 * g_ + i) * 8 + rl] = fminf(z, 0.f) - log1pf(expf(-fabsf(z))); } }
            __syncthreads();
            if (tid < 128) { const int hh = tid & 7, sg = tid >> 3; float s = 0.f;
#pragma unroll
                for (int i = 0; i < 8; ++i) { s += lf[(sg * 8 + i) * 8 + hh]; lf[(sg * 8 + i) * 8 + hh] = s; }
                segs[sg * 8 + hh] = s; }
            __syncthreads();
            if (tid < 8) { float s = 0.f;
#pragma unroll
                for (int i = 0; i < 16; ++i) { const float t_ = segs[i * 8 + tid]; segs[i * 8 + tid] = s; s += t_; }
                ctot[(size_t)ch * 8 + tid] = s; }
            __syncthreads();
            for (int i = tid; i < 1024; i += NWAVES * 64) { const int r_ = i >> 3, hh = i & 7; cl[((size_t)ch * 128 + r_) * 8 + hh] = lf[i] + segs[(r_ >> 3) * 8 + hh]; }
            __syncthreads();
        }
        }
    }
    SEAM(0);

    if (IN(1)) {
        { LAS float* part = (LAS float*)(lds);
          for (int ch = bx; ch < M / 128; ch += G) { const int b_ = ch >> 6, jc = ch & 63, j_ = tid >> 3, hh = tid & 7;
            float v = (j_ < jc) ? ctot[((size_t)b_ * 64 + j_) * NH + hh] : 0.f;
            v += __shfl_xor(v, 8); v += __shfl_xor(v, 16); v += __shfl_xor(v, 32);
            if (lane < 8) part[wave * 8 + lane] = v;
            __syncthreads();
            for (int i = tid; i < 1024; i += NWAVES * 64) { const int h2 = i >> 7, r_ = i & 127; float pre = 0.f;
#pragma unroll
                for (int w_ = 0; w_ < 8; ++w_) pre += part[w_ * 8 + h2];
                cf2[((size_t)b_ * NH + h2) * T + jc * 128 + r_] = (cl[((size_t)ch * 128 + r_) * NH + h2] + pre) * LOG2E; }
            __syncthreads(); } }
        pg8::Gemm g{xb, WinT, M, NQKV, D}; pg8::StaticOrder S; S.init(M, NQKV, G, bx);
        epi::EpiQKV E{qkv, rstd1, nrm};
        pg8::gemm_phase<epi::EpiQKV, pg8::StaticOrder, false>(lds, g, S, E);
    }
    SEAM(1);

    if (IN(2)) {
#ifndef ATT_NP
#define ATT_NP 1
#endif
        att::dil_stream(vcu, qkv, og, lse, cf2, rel_bias, (LAS char*)lds);
#pragma unroll 1
        for (int ps = 0; ps < ATT_NP; ++ps) att::attn_phase<0, 1, ATT_NP>(ps, vcu, qkv, og, lse, of, cf2, nrm, rel_bias, (LAS char*)lds);
    }
    SEAM(2);

    if (IN(3)) {
        const int gw = vcu * NWAVES + wave, NGW = G * NWAVES;
        for (int row0 = gw; row0 < M; row0 += 4 * NGW) {
            float od[4][8], ofx[4][8]; float sd[4] = {0.f, 0.f, 0.f, 0.f}, sf[4] = {0.f, 0.f, 0.f, 0.f};
#pragma unroll
            for (int rr = 0; rr < 4; ++rr) { const int row = (row0 + rr * NGW < M) ? row0 + rr * NGW : row0;
                const int hd = lane >> 3;
                float l0 = lse[((size_t)0 * M + row) * NH + hd], l1 = lse[((size_t)1 * M + row) * NH + hd], l2 = lse[((size_t)2 * M + row) * NH + hd];
                const u32x4 a = *(const u32x4*)(og + ((size_t)0 * M + row) * DH + 8 * lane), b2 = *(const u32x4*)(og + ((size_t)1 * M + row) * DH + 8 * lane), c2 = *(const u32x4*)(og + ((size_t)2 * M + row) * DH + 8 * lane);
                const u32x4 f = *(const u32x4*)(of + (size_t)row * DH + 8 * lane);
                const float mx = fmaxf(l0, fmaxf(l1, l2));
                float e0 = __builtin_amdgcn_exp2f(l0 - mx), e1 = __builtin_amdgcn_exp2f(l1 - mx), e2 = __builtin_amdgcn_exp2f(l2 - mx);
                const float inv = 1.0f / (e0 + e1 + e2); e0 *= inv; e1 *= inv; e2 *= inv;
#pragma unroll
                for (int q = 0; q < 4; ++q) {
                    od[rr][2 * q] = e0 * bf_lo(a[q]) + e1 * bf_lo(b2[q]) + e2 * bf_lo(c2[q]); od[rr][2 * q + 1] = e0 * bf_hi(a[q]) + e1 * bf_hi(b2[q]) + e2 * bf_hi(c2[q]);
                    ofx[rr][2 * q] = bf_lo(f[q]); ofx[rr][2 * q + 1] = bf_hi(f[q]);
                    sd[rr] += od[rr][2 * q] * od[rr][2 * q] + od[rr][2 * q + 1] * od[rr][2 * q + 1]; sf[rr] += ofx[rr][2 * q] * ofx[rr][2 * q] + ofx[rr][2 * q + 1] * ofx[rr][2 * q + 1]; } }
#pragma unroll
            for (int o = 1; o < 64; o <<= 1) {
#pragma unroll
                for (int rr = 0; rr < 4; ++rr) { sd[rr] += __shfl_xor(sd[rr], o); sf[rr] += __shfl_xor(sf[rr], o); } }
#pragma unroll
            for (int rr = 0; rr < 4; ++rr) { const int row = (row0 + rr * NGW < M) ? row0 + rr * NGW : row0;
                const float rd = 1.0f / sqrtf(sd[rr] * (1.0f / DH) + EPS), rf = 1.0f / sqrtf(sf[rr] * (1.0f / DH) + EPS);
                u32x4 o1, o2;
#pragma unroll
                for (int q = 0; q < 4; ++q) { o1[q] = cvt_pk_bf16(od[rr][2 * q] * rd, od[rr][2 * q + 1] * rd); o2[q] = cvt_pk_bf16(ofx[rr][2 * q] * rf, ofx[rr][2 * q + 1] * rf); }
                *(u32x4*)(On + (size_t)row * D + 8 * lane) = o1; *(u32x4*)(On + (size_t)row * D + DH + 8 * lane) = o2; }
        }
    }
    SEAM(3);

    if (IN(4)) {
        pg8::Gemm g{On, WoutT, M, D, D}; pg8::StaticOrder S; S.init(M, D, G, bx);
        epi::EpiRes E{xb, x1b};
        pg8::gemm_phase<epi::EpiRes, pg8::StaticOrder, false>(lds, g, S, E);
    }
    SEAM(4);

    if (IN(5) && !MK_SKIP_MOE) {
        for (int it = tid; it < 48 * 128; it += NWAVES * 64) { const int n = it >> 7, c8 = it & 127, kk = c8 >> 2, g_ = c8 & 3, cb = n >> 4, col = n & 15;
            *(LAS u32x4*)(lds + ((((kk * 3 + cb) * 4 + g_) * 16 + col) * 16)) = *(const u32x4*)(WrT + (size_t)n * D + c8 * 8); }
        LAS float* lg = (LAS float*)(lds + 98304 + wave * 3072);
        LAS int* hist = (LAS int*)(lds + 98304 + 8 * 3072);
        LAS int* gbase = hist + 32;
        __syncthreads();
        for (int ch = bx; ch < M / 128; ch += G) {
            if (tid < 32) hist[tid] = 0;
            const int rl = lane & 15, g_ = lane >> 4; const size_t row = (size_t)ch * 128 + wave * 16 + rl;
            const bf16_t* ar = x1b + row * D + 8 * g_;
            f32x4 acc[3]; acc[0] = (f32x4){0.f, 0.f, 0.f, 0.f}; acc[1] = acc[0]; acc[2] = acc[0];
            float ss = 0.f;
#pragma unroll 16
            for (int kk = 0; kk < 32; ++kk) {
                const bf16x8 a = *(const bf16x8*)(ar + 32 * kk);
                const u32x4 au = __builtin_bit_cast(u32x4, a);
#pragma unroll
                for (int q = 0; q < 4; ++q) { const float lo_ = bf_lo(au[q]), hi_ = bf_hi(au[q]); ss += lo_ * lo_ + hi_ * hi_; }
#pragma unroll
                for (int cb = 0; cb < 3; ++cb) { const bf16x8 bfr = *(const LAS bf16x8*)(lds + ((((kk * 3 + cb) * 4 + g_) * 16 + rl) * 16));
                    acc[cb] = __builtin_amdgcn_mfma_f32_16x16x32_bf16(a, bfr, acc[cb], 0, 0, 0); }
            }
            ss += __shfl_xor(ss, 16); ss += __shfl_xor(ss, 32);
            const float rs2 = 1.0f / sqrtf(ss * (1.0f / D) + EPS);
#pragma unroll
            for (int cb = 0; cb < 3; ++cb)
#pragma unroll
                for (int i = 0; i < 4; ++i) lg[(4 * g_ + i) * 48 + 16 * cb + rl] = acc[cb][i];
            __syncthreads();
            int e_a = 0, e_b = 0, pos_a = 0, pos_b = 0; float w_a = 0.f, w_b = 0.f;
            if (lane < 16) {
                const LAS float* lr = lg + lane * 48;
                float gl[4]; int gi = 0;
#pragma unroll
                for (int i = 0; i < 4; ++i) gl[i] = lr[32 + i] * rs2 + b_rg[i];
                float gm = gl[0];
#pragma unroll
                for (int i = 1; i < 4; ++i) if (gl[i] > gm) { gm = gl[i]; gi = i; }
                float gs = 0.f;
#pragma unroll
                for (int i = 0; i < 4; ++i) gs += expf(gl[i] - gm);
                const float g1 = 1.0f / gs;
                float v1 = -3.0e38f, v2 = -3.0e38f; int i1 = 0, i2 = 0;
#pragma unroll
                for (int i = 0; i < 8; ++i) { const float v = lr[gi * 8 + i] * rs2 + b_re[gi * 8 + i];
                    if (v > v1) { v2 = v1; i2 = i1; v1 = v; i1 = i; } else if (v > v2) { v2 = v; i2 = i; } }
                const float ed = expf(v2 - v1), ga = 1.0f / (1.0f + ed), gb = ed * ga;
                e_a = gi * 8 + i1; e_b = gi * 8 + i2; w_a = g1 * ga; w_b = g1 * gb;
                pos_a = __hip_atomic_fetch_add(hist + e_a, 1, __ATOMIC_RELAXED, __HIP_MEMORY_SCOPE_WORKGROUP); pos_b = __hip_atomic_fetch_add(hist + e_b, 1, __ATOMIC_RELAXED, __HIP_MEMORY_SCOPE_WORKGROUP);
            }
            __syncthreads();
            if (tid < 32) { const int c = hist[tid]; gbase[tid] = c ? (int)__hip_atomic_fetch_add(ctl + CW_ECNT + 64 * tid, (unsigned)c, RLX_AGENT) : 0; }
            __syncthreads();
            if (lane < 16) { const int tok = (int)row;
                const size_t ia = (size_t)e_a * CAP + gbase[e_a] + pos_a, ib = (size_t)e_b * CAP + gbase[e_b] + pos_b;
                list_tok[ia] = tok * 2; list_w[ia] = w_a; list_rs[ia] = rs2;
                list_tok[ib] = tok * 2 + 1; list_w[ib] = w_b; list_rs[ib] = rs2;
                tokmap[tok * 2] = (int)ia; tokmap[tok * 2 + 1] = (int)ib; }
            __syncthreads();
        }
    }
    SEAM(5);

#define MOE_PREFIX() do { LAS int* pre_ = (LAS int*)(lds + MISC_OFF + 64); LAS int* cnt_ = (LAS int*)(lds + MISC_OFF + 256); \
        if (tid == 0) { int s_ = 0; for (int e_ = 0; e_ < NE; ++e_) { const int c_ = (int)__hip_atomic_load(ctl + CW_ECNT + 64 * e_, RLX_AGENT); cnt_[e_] = c_; pre_[e_] = s_; s_ += (c_ + 255) >> 8; } pre_[NE] = s_; } \
        __syncthreads(); } while (0)

    if (IN(6) && !MK_SKIP_MOE) {
        MOE_PREFIX();
        const LAS int* pre = (const LAS int*)(lds + MISC_OFF + 64); const LAS int* cnt = (const LAS int*)(lds + MISC_OFF + 256);
        pg8::Gemm g{x1b, WguT, M, 512, D}; pg8::MoeOrder<1> S{pre, cnt, list_tok, G, vcu};
        epi::EpiGU E{Hb, list_rs, cnt};
        pg8::gemm_phase<epi::EpiGU, pg8::MoeOrder<1>, true>(lds, g, S, E);
    }
    SEAM(6);

    if (IN(7) && !MK_SKIP_MOE) {
        MOE_PREFIX();
        const LAS int* pre = (const LAS int*)(lds + MISC_OFF + 64); const LAS int* cnt = (const LAS int*)(lds + MISC_OFF + 256);
        pg8::Gemm g{Hb, WdT, M, D, DE}; pg8::MoeOrder<2> S{pre, cnt, list_tok, G, vcu};
        epi::EpiDown E{yslot, list_w, cnt};
        pg8::gemm_phase<epi::EpiDown, pg8::MoeOrder<2>, false>(lds, g, S, E);
    }
    SEAM(7);

    if (IN(8)) {
#if !MK_SKIP_MOE
        MOE_PREFIX();
        const LAS int* pre8 = (const LAS int*)(lds + MISC_OFF + 64);
#endif
        const int gw = vcu * NWAVES + wave, NGW = G * NWAVES;
        int tmv = 0;
#if !MK_SKIP_MOE
        { const int rk = gw + (lane >> 1) * NGW; if (lane < 32 && rk < M) tmv = tokmap[rk * 2 + (lane & 1)]; }
#endif
        int kbase = 0;
        for (int row0 = gw; row0 < M; row0 += 4 * NGW, kbase += 4) {
            float v[4][16]; float ss[4] = {0.f, 0.f, 0.f, 0.f};
#pragma unroll
            for (int rr = 0; rr < 4; ++rr) { const int row = (row0 + rr * NGW < M) ? row0 + rr * NGW : row0;
#if !MK_SKIP_MOE
              const int kk_ = (row0 + rr * NGW < M) ? kbase + rr : kbase;
              const int m0 = (kk_ < 16) ? __shfl(tmv, 2 * kk_) : __builtin_amdgcn_readfirstlane(tokmap[row * 2]), m1 = (kk_ < 16) ? __shfl(tmv, 2 * kk_ + 1) : __builtin_amdgcn_readfirstlane(tokmap[row * 2 + 1]);
              const size_t yr0 = (size_t)(pre8[m0 >> 15] * 256 + (m0 & (CAP - 1))), yr1 = (size_t)(pre8[m1 >> 15] * 256 + (m1 & (CAP - 1)));
#endif
#pragma unroll
              for (int hf = 0; hf < 2; ++hf) {
                const size_t co = (size_t)hf * DH + 8 * lane;
                const u32x4 a = *(const u32x4*)(x1b + (size_t)row * D + co);
#if MK_SKIP_MOE
                const u32x2 y0 = (u32x2){0u, 0u}, y1 = y0;
#else
                const u32x2 y0 = *(const u32x2*)(yslot + yr0 * D + co), y1 = *(const u32x2*)(yslot + yr1 * D + co);
#endif
#pragma unroll
                for (int q = 0; q < 4; ++q) { const f32x2 e0 = (q & 1) ? __builtin_amdgcn_cvt_pk_f32_fp8((int)y0[q >> 1], true) : __builtin_amdgcn_cvt_pk_f32_fp8((int)y0[q >> 1], false);
                    const f32x2 e1 = (q & 1) ? __builtin_amdgcn_cvt_pk_f32_fp8((int)y1[q >> 1], true) : __builtin_amdgcn_cvt_pk_f32_fp8((int)y1[q >> 1], false);
                    const float lo_ = bf_lo(a[q]) + (e0.x + e1.x) * 0.0625f, hi_ = bf_hi(a[q]) + (e0.y + e1.y) * 0.0625f;
                    v[rr][hf * 8 + 2 * q] = lo_; v[rr][hf * 8 + 2 * q + 1] = hi_; ss[rr] += lo_ * lo_ + hi_ * hi_; }
              } }
#pragma unroll
            for (int o = 1; o < 64; o <<= 1) { ss[0] += __shfl_xor(ss[0], o); ss[1] += __shfl_xor(ss[1], o); ss[2] += __shfl_xor(ss[2], o); ss[3] += __shfl_xor(ss[3], o); }
#pragma unroll
            for (int rr = 0; rr < 4; ++rr) { const int row = (row0 + rr * NGW < M) ? row0 + rr * NGW : row0;
              const float rs = 1.0f / sqrtf(ss[rr] * (1.0f / D) + EPS);
#pragma unroll
              for (int hf = 0; hf < 2; ++hf) { const size_t co = (size_t)hf * DH + 8 * lane;
                const f32x4 g0 = *(const f32x4*)(final_norm + co), g1 = *(const f32x4*)(final_norm + co + 4);
                f32x4 o0, o1;
#pragma unroll
                for (int q = 0; q < 4; ++q) { o0[q] = v[rr][hf * 8 + q] * rs * g0[q]; o1[q] = v[rr][hf * 8 + 4 + q] * rs * g1[q]; }
                *(f32x4*)(args.out + (size_t)row * D + co) = o0; *(f32x4*)(args.out + (size_t)row * D + co + 4) = o1; } }
        }
    }
#undef IN
#undef SEAM
}

#ifndef MK_N_LAUNCHES
#define MK_N_LAUNCHES 1
#endif
extern "C" void kernel_launch(void* const* d_in, const int* in_sizes, int n_in, void* d_out, int out_size, void* d_ws, size_t ws_size, hipStream_t stream) {
    static int grid = 0;
    if (grid == 0) {
        if (n_in != 17 || in_sizes[0] != M * D || out_size != M * D || ws_size < WS_END) { fprintf(stderr, "kernel_launch: unexpected shapes (n_in %d in0 %d out %d ws %zu)\n", n_in, n_in > 0 ? in_sizes[0] : -1, out_size, ws_size); grid = -1; return; }
        int dev = 0, cus = 0, per_cu = 0;
        if (hipGetDevice(&dev) != hipSuccess || hipDeviceGetAttribute(&cus, hipDeviceAttributeMultiprocessorCount, dev) != hipSuccess) { grid = -1; return; }
        if (hipFuncSetAttribute((const void*)hymba_fwd, hipFuncAttributeMaxDynamicSharedMemorySize, LDS_BYTES) != hipSuccess) { fprintf(stderr, "kernel_launch: hipFuncSetAttribute failed\n"); grid = -1; return; }
        if (hipOccupancyMaxActiveBlocksPerMultiprocessor(&per_cu, (const void*)hymba_fwd, NWAVES * 64, LDS_BYTES) != hipSuccess || per_cu < 1) { fprintf(stderr, "kernel_launch: occupancy query says %d\n", per_cu); }
        (void)hipGetLastError();
        if (cus < 256) { fprintf(stderr, "kernel_launch: this kernel is built for the 256 CUs of MI355X (device reports %d)\n", cus); grid = -1; return; }
        grid = 256;
    }
    if (grid < 0) return;
    (void)hipMemsetAsync((char*)d_ws + WS_CTL, 0, CTL_ZERO_BYTES, stream);
    Args a{};
    for (int i = 0; i < 17; ++i) a.in[i] = (const float*)d_in[i];
    a.out = (float*)d_out; a.ws = (unsigned char*)d_ws;
#if MK_N_LAUNCHES == 1
    a.ph_lo = 0; a.ph_hi = N_PHASES;
    hipLaunchKernelGGL(hymba_fwd, dim3(grid), dim3(NWAVES * 64), LDS_BYTES, stream, a);
#else
    for (int p = 0; p < N_PHASES; ++p) { a.ph_lo = p; a.ph_hi = p + 1; hipLaunchKernelGGL(hymba_fwd, dim3(grid), dim3(NWAVES * 64), LDS_BYTES, stream, a); }
#endif
}
```
